# Optimizing an MI355X kernel written in HIP

```python
import jax
import jax.numpy as jnp
from jax import lax
import numpy as np

D_MODEL = 1024
BATCH = 16
SEQ = 256
DEPTH = 2
DEC_BATCH = 4
DEC_SEQ = 4096
PAST_LEN = 512

GRID_W = 64
N_EVEN = (DEPTH + 1) // 2
N_ODD = DEPTH // 2
RET_HEADS = 4
RET_DK = 64
RET_DV = 128
GDN_HEADS = 4
GDN_DK = 128
GDN_DV = 128
CONV_W = 3
CHUNK = 64
ATT_HEADS = 16
ATT_KV_HEADS = 4
ATT_HD = 64
ATT_GROUP = ATT_HEADS // ATT_KV_HEADS
Q_BLOCK = 128
ROPE_THETA = 10000.0
ROPE_PAIRS = ATT_HD // 4
FFN_HIDDEN = 2816
N_MOD = 9
EPS = 1e-6

RET_QK = RET_HEADS * RET_DK
RET_V = RET_HEADS * RET_DV
GDN_QK = GDN_HEADS * GDN_DK
GDN_V = GDN_HEADS * GDN_DV
EVEN_SPLITS = (RET_QK, RET_QK, RET_V, RET_V, GDN_QK, GDN_QK, GDN_V, GDN_V, 2 * GDN_HEADS, 2 * GDN_HEADS)
EVEN_IN = 2 * RET_QK + 2 * RET_V + 2 * GDN_QK + 2 * GDN_V + 4 * GDN_HEADS
EVEN_OUT = RET_V + GDN_V
ATT_Q = ATT_HEADS * ATT_HD
ATT_KV = ATT_KV_HEADS * ATT_HD
ODD_IN = ATT_Q + 2 * ATT_KV
ODD_OUT = ATT_Q

kernel_name = 'hybrid_prefix_dit_retention_gdn_gqa_step'


def _split(x, sizes):
    out, start = [], 0
    for s in sizes:
        out.append(x[..., start:start + s])
        start += s
    return out


def rmsnorm(x, w):
    xf = x.astype(jnp.float32)
    y = xf * lax.rsqrt(jnp.mean(xf * xf, axis=-1, keepdims=True) + EPS)
    return (y * w.astype(jnp.float32)).astype(x.dtype)


def l2norm(x):
    xf = x.astype(jnp.float32)
    return (xf * lax.rsqrt(jnp.sum(xf * xf, axis=-1, keepdims=True) + EPS)).astype(x.dtype)


def modulation(cond, w, b):
    m = jax.nn.silu(cond) @ w + b
    return m.reshape(cond.shape[0], N_MOD, D_MODEL)


def ada_norm(x, w, m, j):
    shift, scale = m[:, None, 3 * j], m[:, None, 3 * j + 1]
    return rmsnorm(x, w) * (1 + scale) + shift


def ffn_sublayer(x, m, j, w_norm, w_in, w_out):
    h = ada_norm(x, w_norm, m, j)
    a, b = _split(h @ w_in, (FFN_HIDDEN, FFN_HIDDEN))
    return x + 0.5 * m[:, None, 3 * j + 2] * ((jax.nn.silu(a) * b) @ w_out)


def _chunks(x):
    b, h, t = x.shape[:3]
    return x.reshape((b, h, t // CHUNK, CHUNK) + x.shape[3:])


def _decay_matrix(gc):
    causal = jnp.tril(jnp.ones((CHUNK, CHUNK), dtype=bool))
    diff = gc[..., :, None] - gc[..., None, :]
    return jnp.exp(jnp.where(causal, diff, -jnp.inf))


def chunk_decay_linear_attn(q, k, v, g, s0):
    out_dtype = q.dtype
    b, h, t, dv = v.shape
    qc, kc, vc = (_chunks(a.astype(jnp.float32)) for a in (q, k, v))
    gc = jnp.cumsum(_chunks(g.astype(jnp.float32)), axis=-1)
    decay = _decay_matrix(gc)
    scores = jnp.einsum('bhncd,bhnsd->bhncs', qc, kc) * decay
    o_intra = jnp.einsum('bhncs,bhnsv->bhncv', scores, vc)
    q_dec = qc * jnp.exp(gc)[..., None]
    k_dec = kc * jnp.exp(gc[..., -1:] - gc)[..., None]
    chunk_decay = jnp.exp(gc[..., -1])

    def step(state, xs):
        qd, kd, vv, cd = xs
        o = jnp.einsum('bhcd,bhdv->bhcv', qd, state)
        state = state * cd[..., None, None] + jnp.einsum('bhcd,bhcv->bhdv', kd, vv)
        return state, o

    xs = tuple(jnp.moveaxis(a, 2, 0) for a in (q_dec, k_dec, vc, chunk_decay))
    s_fin, o_inter = lax.scan(step, s0.astype(jnp.float32), xs)
    o = o_intra + jnp.moveaxis(o_inter, 0, 2)
    return o.reshape(b, h, t, dv).astype(out_dtype), s_fin


def chunk_gated_delta_rule(q, k, v, g, beta, s0):
    out_dtype = q.dtype
    b, h, t, dv = v.shape
    q, k, v = (a.astype(jnp.float32) for a in (q, k, v))
    beta = beta.astype(jnp.float32)[..., None]
    qc, kc = _chunks(q), _chunks(k)
    kbc, vbc = _chunks(k * beta), _chunks(v * beta)
    gc = jnp.cumsum(_chunks(g.astype(jnp.float32)), axis=-1)
    decay = _decay_matrix(gc)
    strict = jnp.tril(jnp.ones((CHUNK, CHUNK), dtype=bool), -1)
    m = jnp.where(strict, jnp.einsum('bhncd,bhnsd->bhncs', kbc, kc) * decay, 0.0)
    a_mat = m + jnp.eye(CHUNK, dtype=jnp.float32)
    rhs = jnp.concatenate([vbc, kbc * jnp.exp(gc)[..., None]], axis=-1)
    sol = lax.linalg.triangular_solve(a_mat, rhs, left_side=True, lower=True, unit_diagonal=True)
    u, w = sol[..., :dv], sol[..., dv:]
    attn = jnp.einsum('bhncd,bhnsd->bhncs', qc, kc) * decay
    q_dec = qc * jnp.exp(gc)[..., None]
    k_dec = kc * jnp.exp(gc[..., -1:] - gc)[..., None]
    chunk_decay = jnp.exp(gc[..., -1])

    def step(state, xs):
        qd, kd, uu, ww, at, cd = xs
        v_new = uu - jnp.einsum('bhcd,bhdv->bhcv', ww, state)
        o = jnp.einsum('bhcd,bhdv->bhcv', qd, state) + jnp.einsum('bhcs,bhsv->bhcv', at, v_new)
        state = state * cd[..., None, None] + jnp.einsum('bhcd,bhcv->bhdv', kd, v_new)
        return state, o

    xs = tuple(jnp.moveaxis(a, 2, 0) for a in (q_dec, k_dec, u, w, attn, chunk_decay))
    s_fin, o = lax.scan(step, s0.astype(jnp.float32), xs)
    o = jnp.moveaxis(o, 0, 2)
    return o.reshape(b, h, t, dv).astype(out_dtype), s_fin


def short_conv(x, w):
    return lax.conv_general_dilated(
        x, w[:, None, :].astype(x.dtype), window_strides=(1,),
        padding=[(CONV_W // 2, CONV_W // 2)], dimension_numbers=('NWC', 'WIO', 'NWC'),
        feature_group_count=x.shape[-1])


def even_mixer(h, w_in, w_out, decay_logit, ret_norm_w, conv_w, a_log, dt_bias, gdn_norm_w, s0_ret, s0_gdn):
    b, t, _ = h.shape
    rq, rk, rv, rg, gq, gk, gv, gg, ga, gb = _split(h @ w_in, EVEN_SPLITS)

    def heads(x, n):
        return x.reshape(b, t, n, -1).transpose(0, 2, 1, 3)

    def flip(x):
        return jnp.flip(x, axis=2)

    rq_h = heads(rq, RET_HEADS)
    rk_h = heads(rk, RET_HEADS) * RET_DK ** -0.5
    rv_h = heads(rv, RET_HEADS)
    log_gamma = jax.nn.log_sigmoid(decay_logit.astype(jnp.float32))
    g_f = jnp.broadcast_to(log_gamma[0][None, :, None], (b, RET_HEADS, t))
    g_b = jnp.broadcast_to(log_gamma[1][None, :, None], (b, RET_HEADS, t))
    o_f, sr_f = chunk_decay_linear_attn(rq_h, rk_h, rv_h, g_f, s0_ret[:, 0])
    o_b, sr_b = chunk_decay_linear_attn(flip(rq_h), flip(rk_h), flip(rv_h), g_b, s0_ret[:, 1])
    ret = rmsnorm(o_f + flip(o_b), ret_norm_w).transpose(0, 2, 1, 3).reshape(b, t, RET_V)
    ret = ret * jax.nn.silu(rg)

    qkv = jax.nn.silu(short_conv(jnp.concatenate([gq, gk, gv], axis=-1), conv_w))
    cq, ck, cv = _split(qkv, (GDN_QK, GDN_QK, GDN_V))
    q = l2norm(heads(cq, GDN_HEADS)) * GDN_DK ** -0.5
    k = l2norm(heads(ck, GDN_HEADS))
    v = heads(cv, GDN_HEADS)
    ga = ga.reshape(b, t, 2, GDN_HEADS).astype(jnp.float32)
    gb = gb.reshape(b, t, 2, GDN_HEADS).astype(jnp.float32)
    g = -jnp.exp(a_log.astype(jnp.float32)) * jax.nn.softplus(ga + dt_bias.astype(jnp.float32))
    g = g.transpose(2, 0, 3, 1)
    beta = jax.nn.sigmoid(gb).transpose(2, 0, 3, 1)
    od_f, sg_f = chunk_gated_delta_rule(q, k, v, g[0], beta[0], s0_gdn[:, 0])
    od_b, sg_b = chunk_gated_delta_rule(flip(q), flip(k), flip(v), jnp.flip(g[1], axis=-1),
                                        jnp.flip(beta[1], axis=-1), s0_gdn[:, 1])
    gdn = rmsnorm(od_f + flip(od_b), gdn_norm_w).transpose(0, 2, 1, 3).reshape(b, t, GDN_V)
    gdn = gdn * jax.nn.silu(gg)

    out = jnp.concatenate([ret, gdn], axis=-1) @ w_out
    return out, jnp.stack([sr_f, sr_b], axis=1), jnp.stack([sg_f, sg_b], axis=1)


def _rotate(x, ang):
    n = ang.shape[-1]
    cos = jnp.cos(ang)[None, :, None, :]
    sin = jnp.sin(ang)[None, :, None, :]
    xf = x.astype(jnp.float32)
    x1, x2 = xf[..., :n], xf[..., n:]
    return jnp.concatenate([x1 * cos - x2 * sin, x2 * cos + x1 * sin], axis=-1)


def axial_rope(x):
    t = x.shape[1]
    rows = t // GRID_W
    row = jnp.repeat(jnp.arange(rows, dtype=jnp.float32), GRID_W)
    col = (jnp.arange(rows * GRID_W) % GRID_W).astype(jnp.float32)
    inv = ROPE_THETA ** (-jnp.arange(ROPE_PAIRS, dtype=jnp.float32) / ROPE_PAIRS)
    half = ATT_HD // 2
    xr = _rotate(x[..., :half], row[:, None] * inv)
    xc = _rotate(x[..., half:], col[:, None] * inv)
    return jnp.concatenate([xr, xc], axis=-1).astype(x.dtype)


def block_attention(q, k, v):
    b, tq = q.shape[:2]
    nb = tq // Q_BLOCK
    qb = q.reshape(b, nb, Q_BLOCK, ATT_KV_HEADS, ATT_GROUP, ATT_HD).transpose(1, 0, 2, 3, 4, 5)
    scale = ATT_HD ** -0.5

    def one_block(qi):
        s = jnp.einsum('bqhgd,bkhd->bhgqk', qi, k, preferred_element_type=jnp.float32) * scale
        p = jax.nn.softmax(s, axis=-1).astype(v.dtype)
        return jnp.einsum('bhgqk,bkhd->bqhgd', p, v)

    o = lax.map(one_block, qb)
    return o.transpose(1, 0, 2, 3, 4, 5).reshape(b, tq, ATT_HEADS * ATT_HD)


def odd_mixer(h, w_in, w_out, q_norm_w, k_norm_w, ctx_k=None, ctx_v=None):
    b, t, _ = h.shape
    q, k, v = _split(h @ w_in, (ATT_Q, ATT_KV, ATT_KV))
    q = rmsnorm(q.reshape(b, t, ATT_HEADS, ATT_HD), q_norm_w)
    k = rmsnorm(k.reshape(b, t, ATT_KV_HEADS, ATT_HD), k_norm_w)
    v = v.reshape(b, t, ATT_KV_HEADS, ATT_HD)
    if ctx_k is None:
        o = block_attention(q, k, v)
    else:
        q, k = axial_rope(q), axial_rope(k)
        o = block_attention(q, jnp.concatenate([ctx_k, k], axis=1), jnp.concatenate([ctx_v, v], axis=1))
    return o @ w_out, k, v


def setup_inputs(seed: int = 0) -> dict:
    key = jax.random.key(seed)
    ks = jax.random.split(key, 26)
    f32 = jnp.float32

    def nrm(k, shape, s):
        return jax.random.normal(k, shape, f32) * s

    gamma = 1.0 - 2.0 ** (-5.0 - jnp.arange(RET_HEADS, dtype=f32))
    dt = jnp.exp(jax.random.uniform(ks[19], (N_EVEN, 2, GDN_HEADS), f32, np.log(1e-3), np.log(1e-1)))
    return {
        'x_prompt': nrm(ks[0], (BATCH, SEQ, D_MODEL), 1.0),
        'x_sample': nrm(ks[1], (DEC_BATCH, DEC_SEQ, D_MODEL), 1.0),
        'state_ret': nrm(ks[2], (DEC_BATCH, N_EVEN, 2, RET_HEADS, RET_DK, RET_DV), 0.5),
        'state_gdn': nrm(ks[3], (DEC_BATCH, N_EVEN, 2, GDN_HEADS, GDN_DK, GDN_DV), 0.5),
        'cache_k': nrm(ks[4], (DEC_BATCH, N_ODD, PAST_LEN, ATT_KV_HEADS, ATT_HD), 1.0),
        'cache_v': nrm(ks[5], (DEC_BATCH, N_ODD, PAST_LEN, ATT_KV_HEADS, ATT_HD), 1.0),
        'c': nrm(ks[6], (DEC_BATCH, D_MODEL), 1.0),
        'c_ctx': nrm(ks[7], (D_MODEL,), 1.0),
        'mod_w': nrm(ks[8], (DEPTH, D_MODEL, N_MOD * D_MODEL), 0.02),
        'mod_b': nrm(ks[9], (DEPTH, N_MOD * D_MODEL), 0.02),
        'norm_w': 1.0 + nrm(ks[10], (DEPTH, 3, D_MODEL), 0.02),
        'ffn_w_in': nrm(ks[11], (DEPTH, 2, D_MODEL, 2 * FFN_HIDDEN), D_MODEL ** -0.5),
        'ffn_w_out': nrm(ks[12], (DEPTH, 2, FFN_HIDDEN, D_MODEL), FFN_HIDDEN ** -0.5),
        'even_w_in': nrm(ks[13], (N_EVEN, D_MODEL, EVEN_IN), D_MODEL ** -0.5),
        'even_w_out': nrm(ks[14], (N_EVEN, EVEN_OUT, D_MODEL), EVEN_OUT ** -0.5),
        'ret_decay_logit': jnp.log(gamma / (1.0 - gamma)) + nrm(ks[15], (N_EVEN, 2, RET_HEADS), 0.1),
        'ret_norm_w': 1.0 + nrm(ks[16], (N_EVEN, RET_DV), 0.02),
        'gdn_conv_w': nrm(ks[17], (N_EVEN, CONV_W, 2 * GDN_QK + GDN_V), CONV_W ** -0.5),
        'gdn_A_log': jnp.log(jax.random.uniform(ks[18], (N_EVEN, 2, GDN_HEADS), f32, 1.0, 16.0)),
        'gdn_dt_bias': dt + jnp.log(-jnp.expm1(-dt)),
        'gdn_norm_w': 1.0 + nrm(ks[20], (N_EVEN, GDN_DV), 0.02),
        'odd_w_in': nrm(ks[21], (N_ODD, D_MODEL, ODD_IN), D_MODEL ** -0.5),
        'odd_w_out': nrm(ks[22], (N_ODD, ODD_OUT, D_MODEL), ODD_OUT ** -0.5),
        'q_norm_w': 1.0 + nrm(ks[23], (N_ODD, ATT_HD), 0.02),
        'k_norm_w': 1.0 + nrm(ks[24], (N_ODD, ATT_HD), 0.02),
        'final_norm_w': 1.0 + nrm(ks[25], (D_MODEL,), 0.02),
    }


def reference(x_prompt, x_sample, state_ret, state_gdn, cache_k, cache_v, c, c_ctx,
              mod_w, mod_b, norm_w, ffn_w_in, ffn_w_out, even_w_in, even_w_out,
              ret_decay_logit, ret_norm_w, gdn_conv_w, gdn_A_log, gdn_dt_bias, gdn_norm_w,
              odd_w_in, odd_w_out, q_norm_w, k_norm_w, final_norm_w):
    xp, xs = x_prompt, x_sample
    bp = xp.shape[0]
    zero_ret = jnp.zeros((bp, 2, RET_HEADS, RET_DK, RET_DV), jnp.float32)
    zero_gdn = jnp.zeros((bp, 2, GDN_HEADS, GDN_DK, GDN_DV), jnp.float32)
    new_ret, new_gdn, new_k, new_v = [], [], [], []
    for l in range(DEPTH):
        mp = modulation(c_ctx[None], mod_w[l], mod_b[l])
        ms = modulation(c, mod_w[l], mod_b[l])
        xp = ffn_sublayer(xp, mp, 0, norm_w[l, 0], ffn_w_in[l, 0], ffn_w_out[l, 0])
        xs = ffn_sublayer(xs, ms, 0, norm_w[l, 0], ffn_w_in[l, 0], ffn_w_out[l, 0])
        hp = ada_norm(xp, norm_w[l, 1], mp, 1)
        hs = ada_norm(xs, norm_w[l, 1], ms, 1)
        if l % 2 == 0:
            e = l // 2
            prm = (even_w_in[e], even_w_out[e], ret_decay_logit[e], ret_norm_w[e], gdn_conv_w[e],
                   gdn_A_log[e], gdn_dt_bias[e], gdn_norm_w[e])
            op, sr, sg = even_mixer(hp, *prm, zero_ret, zero_gdn)
            os_, _, _ = even_mixer(hs, *prm, state_ret[:, e], state_gdn[:, e])
            new_ret.append(sr)
            new_gdn.append(sg)
        else:
            o = l // 2
            prm = (odd_w_in[o], odd_w_out[o], q_norm_w[o], k_norm_w[o])
            op, kp, vp = odd_mixer(hp, *prm)
            os_, _, _ = odd_mixer(hs, *prm, cache_k[:, o], cache_v[:, o])
            new_k.append(kp)
            new_v.append(vp)
        xp = xp + mp[:, None, 5] * op
        xs = xs + ms[:, None, 5] * os_
        xp = ffn_sublayer(xp, mp, 2, norm_w[l, 2], ffn_w_in[l, 1], ffn_w_out[l, 1])
        xs = ffn_sublayer(xs, ms, 2, norm_w[l, 2], ffn_w_in[l, 1], ffn_w_out[l, 1])
    y_prompt = rmsnorm(xp, final_norm_w)
    y_sample = rmsnorm(xs, final_norm_w)
    new_state_ret = jnp.stack(new_ret, axis=1)
    new_state_gdn = jnp.stack(new_gdn, axis=1)
    new_cache_k = jnp.stack(new_k, axis=1)
    new_cache_v = jnp.stack(new_v, axis=1)
    return (y_prompt, y_sample, new_state_ret, new_state_gdn, new_cache_k, new_cache_v)
```

```cpp
#include <hip/hip_runtime.h>
#include <hip/hip_cooperative_groups.h>
#include <hip/hip_bf16.h>
#include <cstdint>
#include <cstdio>
#include <cmath>
namespace cg = cooperative_groups;

#define LAS __attribute__((address_space(3)))
typedef unsigned short bf16_t;
typedef short bf16x8 __attribute__((ext_vector_type(8)));
typedef short s16x4 __attribute__((ext_vector_type(4)));
typedef float f32x4 __attribute__((ext_vector_type(4)));
typedef float f32x2 __attribute__((ext_vector_type(2)));
typedef unsigned u32x4 __attribute__((ext_vector_type(4)));
typedef unsigned u32x2 __attribute__((ext_vector_type(2)));

constexpr int DM = 1024, NPR = 4096, NLA = 16384, MROWS = 20480, FFH = 2816, FF2 = 5632;
constexpr int EVN = 3584;
constexpr int EVFULL = 3600, ODN = 1536;
constexpr int NCHUNK = MROWS / 64;
constexpr float EPS = 1e-6f;
constexpr float LOG2E = 1.4426950408889634f;
constexpr float ATT_C2 = 0.125f * 1.4426950408889634f;

constexpr size_t OUT_Y = 0, OUT_SRET = (size_t)MROWS * DM, OUT_SGDN = OUT_SRET + 16 * 2 * 4 * 64 * 128,
                 OUT_CK = OUT_SGDN + 16 * 2 * 4 * 128 * 128, OUT_CV = OUT_CK + 16 * 256 * 256, OUT_END = OUT_CV + 16 * 256 * 256;

constexpr size_t MiB = 1u << 20;
constexpr size_t WS_CTL = 0;
constexpr size_t WS_MOD = 1 * MiB;
constexpr size_t WS_PTAB = 1 * MiB + 448 * 1024;
constexpr size_t WS_ROPE = 1 * MiB + 512 * 1024;
constexpr size_t WS_GW = 1 * MiB + 768 * 1024;
constexpr size_t WS_WFIN0 = 2 * MiB, WS_WFOUT0 = 13 * MiB, WS_WFIN1 = 18 * MiB + 512 * 1024, WS_WFOUT1 = 29 * MiB + 512 * 1024,
                 WS_WMIN = 35 * MiB, WS_WMOUT = 42 * MiB;
constexpr size_t WS_XN = 44 * MiB;
constexpr size_t WS_QN = WS_XN, WS_KNT = WS_XN + 20 * MiB;
constexpr size_t WS_BIG = 84 * MiB;
constexpr size_t WS_U = 224 * MiB, WS_W = 264 * MiB;
constexpr size_t WS_ATT = 304 * MiB;
constexpr size_t WS_GC = 324 * MiB;
constexpr size_t WS_GATES = 336 * MiB;
constexpr size_t WS_END = 352 * MiB;
constexpr size_t WS_Q = 224 * MiB;
constexpr size_t WS_KL = 264 * MiB, WS_VL = 273 * MiB;
constexpr size_t WS_KP = 282 * MiB, WS_VP = 284 * MiB;
constexpr size_t WS_SLAB = 265 * MiB;

struct Params {
    const float *x_prompt, *x_sample, *state_ret, *state_gdn, *cache_k, *cache_v, *c, *c_ctx, *mod_w, *mod_b, *norm_w, *ffn_w_in, *ffn_w_out,
        *even_w_in, *even_w_out, *ret_decay_logit, *ret_norm_w, *gdn_conv_w, *gdn_A_log, *gdn_dt_bias, *gdn_norm_w, *odd_w_in, *odd_w_out,
        *q_norm_w, *k_norm_w, *final_norm_w;
    float* out; unsigned char* ws;
};

template <class T> __device__ __forceinline__ T* as_global(T* p) { return (T*)(__attribute__((address_space(1))) T*)(uintptr_t)p; }
__device__ __forceinline__ float bf2f(unsigned short b) { return __uint_as_float((unsigned)b << 16); }
__device__ __forceinline__ float bflo(unsigned w) { return __uint_as_float(w << 16); }
__device__ __forceinline__ float bfhi(unsigned w) { return __uint_as_float(w & 0xffff0000u); }
typedef __bf16 bf16x2_t __attribute__((ext_vector_type(2)));
__device__ __forceinline__ unsigned pk2(float lo, float hi) { f32x2 v = {lo, hi}; bf16x2_t b = __builtin_convertvector(v, bf16x2_t); return __builtin_bit_cast(unsigned, b); }
__device__ __forceinline__ unsigned short f2bf(float f) { return (unsigned short)(pk2(f, 0.f) & 0xffffu); }
__device__ __forceinline__ int fresh_lane() { int z; asm volatile("s_mov_b32 %0, 0" : "=s"(z)); return (int)__builtin_amdgcn_mbcnt_hi(~0u, __builtin_amdgcn_mbcnt_lo(~0u, (unsigned)z)); }
__device__ __forceinline__ float shx(float v, int o, int lane) { return __builtin_bit_cast(float, __builtin_amdgcn_ds_bpermute((lane ^ o) << 2, __builtin_bit_cast(int, v))); }
__device__ __forceinline__ float dpp_add(float v, const int ctrl_sel) {
    int t;
    if (ctrl_sel == 0) t = __builtin_amdgcn_update_dpp(0, __builtin_bit_cast(int, v), 0xB1, 0xF, 0xF, false);
    else if (ctrl_sel == 1) t = __builtin_amdgcn_update_dpp(0, __builtin_bit_cast(int, v), 0x4E, 0xF, 0xF, false);
    else if (ctrl_sel == 2) t = __builtin_amdgcn_update_dpp(0, __builtin_bit_cast(int, v), 0x141, 0xF, 0xF, false);
    else t = __builtin_amdgcn_update_dpp(0, __builtin_bit_cast(int, v), 0x140, 0xF, 0xF, false);
    return v + __builtin_bit_cast(float, t);
}
__device__ __forceinline__ float row16_sum(float v) { v = dpp_add(v, 0); v = dpp_add(v, 1); v = dpp_add(v, 2); v = dpp_add(v, 3); return v; }
__device__ __forceinline__ float wave_sum(float v, int) {
    v = row16_sum(v);
    { auto r = __builtin_amdgcn_permlane16_swap(__float_as_uint(v), __float_as_uint(v), false, false); v = __uint_as_float(r[0]) + __uint_as_float(r[1]); }
    { auto r = __builtin_amdgcn_permlane32_swap(__float_as_uint(v), __float_as_uint(v), false, false); v = __uint_as_float(r[0]) + __uint_as_float(r[1]); }
    return v;
}
__device__ __forceinline__ float silu_f(float a) { return a * __builtin_amdgcn_rcpf(1.f + __builtin_amdgcn_exp2f(-LOG2E * a)); }
__device__ __forceinline__ float sigmoid_f(float a) { return __builtin_amdgcn_rcpf(1.f + __builtin_amdgcn_exp2f(-LOG2E * a)); }
__device__ __forceinline__ bf16x8 pack8(const f32x4 a, const f32x4 b) {
    u32x4 w; w.x = pk2(a[0], a[1]); w.y = pk2(a[2], a[3]); w.z = pk2(b[0], b[1]); w.w = pk2(b[2], b[3]); return __builtin_bit_cast(bf16x8, w);
}
__device__ __forceinline__ f32x4 mfma16(bf16x8 a, bf16x8 b, f32x4 c) { return __builtin_amdgcn_mfma_f32_16x16x32_bf16(a, b, c, 0, 0, 0); }
__device__ __forceinline__ int mod_index(int row) { return row < NPR ? 0 : 1 + ((row - NPR) >> 12); }
#define RLX_AGENT __ATOMIC_RELAXED, __HIP_MEMORY_SCOPE_AGENT
#define XB_TMO      128
#define XB_XCNT(j)  (256  + 64 * (j))
#define XB_XSUB(j)  (1280 + 64 * (j))
#define XB_XGEN(j)  (2304 + 64 * (j))
#define XB_TOP      3328
#define XB_TOPGEN   3392
#define XCD_BAR_WORDS 3456
#define XB_SPIN_CAP (1u << 18)

__device__ __forceinline__ unsigned xb_ld(unsigned* p)              { return __hip_atomic_load(p, __ATOMIC_RELAXED, __HIP_MEMORY_SCOPE_AGENT); }
__device__ __forceinline__ unsigned xb_add(unsigned* p, unsigned v) { return __hip_atomic_fetch_add(p, v, __ATOMIC_RELAXED, __HIP_MEMORY_SCOPE_AGENT); }
__device__ __forceinline__ unsigned xb_xcc_id() { return (unsigned)__builtin_amdgcn_readfirstlane((int)(__builtin_amdgcn_s_getreg((3 << 11) | 20) & 0xFu)); }
#define XB_SPIN(cond, bar) do { unsigned _sp = 0; while (cond) { __builtin_amdgcn_s_sleep(1); \
    if ((++_sp & 255u) == 0u) { if (xb_ld(&(bar)[XB_TMO])) break; if (_sp > XB_SPIN_CAP) { atomicAdd(&(bar)[XB_TMO], 1u); break; } } } } while (0)

struct XcdBarrier {
    unsigned* bar; unsigned x;
    volatile LAS unsigned* st;
};

__device__ __forceinline__ XcdBarrier xcd_barrier_post(unsigned* bar, volatile LAS unsigned* st, const bool leader) {
    XcdBarrier b; b.bar = bar; b.x = xb_xcc_id(); b.st = st;
    if (leader) (void)xb_add(&bar[XB_XCNT(b.x)], 1u);
    return b;
}
__device__ __forceinline__ void xcd_barrier_complete(unsigned* bar, unsigned x, unsigned& nloc, unsigned& nx) {
    const unsigned G = gridDim.x * gridDim.y * gridDim.z;
    unsigned sum, cnt, mine, sp = 0u;
    for (;;) {
        sum = 0u; cnt = 0u; mine = 0u;
#pragma unroll
        for (unsigned j = 0; j < 16; ++j) { const unsigned c = xb_ld(&bar[XB_XCNT(j)]); sum += c; cnt += (c > 0u) ? 1u : 0u; mine = (j == x) ? c : mine; }
        if (sum == G) break;
        __builtin_amdgcn_s_sleep(1);
        if ((++sp & 255u) == 0u) { if (xb_ld(&bar[XB_TMO])) break; if (sp > XB_SPIN_CAP) { atomicAdd(&bar[XB_TMO], 1u); break; } }
    }
    nloc = mine > 0u ? mine : 1u; nx = cnt > 0u ? cnt : 1u;
}

__device__ __forceinline__ void xcd_barrier(const XcdBarrier& b, const bool leader) {
    asm volatile("s_waitcnt vmcnt(0)" ::: "memory");
    __syncthreads();
    if (leader) {
        unsigned* bar = b.bar;
        __builtin_amdgcn_s_waitcnt(0);
        unsigned nloc = b.st[0], nx = b.st[1];
        if (nloc == 0u) { xcd_barrier_complete(bar, b.x, nloc, nx); b.st[0] = nloc; b.st[1] = nx; }
        const unsigned old = xb_add(&bar[XB_XSUB(b.x)], 1u);
        const unsigned gen = old / nloc;
        if (old + 1u == (gen + 1u) * nloc) {
            __builtin_amdgcn_fence(__ATOMIC_RELEASE, "agent");
            asm volatile("s_waitcnt vmcnt(0)" ::: "memory");
            const unsigned og = xb_add(&bar[XB_TOP], 1u);
            const unsigned tg = og / nx;
            if (og + 1u == (tg + 1u) * nx) xb_add(&bar[XB_TOPGEN], 1u);
            else XB_SPIN(xb_ld(&bar[XB_TOPGEN]) == tg, bar);
            __builtin_amdgcn_fence(__ATOMIC_ACQUIRE, "agent");
            xb_add(&bar[XB_XGEN(b.x)], 1u);
            asm volatile("s_waitcnt vmcnt(0)" ::: "memory");
        } else {
            XB_SPIN(xb_ld(&bar[XB_XGEN(b.x)]) == gen, bar);
            __builtin_amdgcn_fence(__ATOMIC_ACQUIRE, "agent");
            asm volatile("s_waitcnt vmcnt(0)" ::: "memory");
        }
    }
    __syncthreads();
}
namespace pg8 {
#define PG8_LAS __attribute__((address_space(3)))
typedef unsigned short bf16_t;
typedef short bf16x8 __attribute__((ext_vector_type(8)));
typedef float f32x4 __attribute__((ext_vector_type(4)));
typedef unsigned u32x4 __attribute__((ext_vector_type(4)));
constexpr int BM = 256, BK = 64, HALF = 128, HTB = HALF * BK * 2  , STAGE_BYTES = 8 * HTB, NXCD = 8, WGM = 8;

__host__ __device__ __forceinline__ int lds_byte(int r, int c) { const int st = (r >> 4) * 2 + (c >> 5), rr = r & 15, cc = c & 31, ob = rr * 64 + cc * 2; return st * 1024 + (ob ^ (((ob >> 9) & 1) << 5)); }
__host__ __device__ __forceinline__ void stage_rc(int b, int& R, int& C) { const int st = b / 1024, sb = b % 1024, swz = sb ^ (((sb >> 9) & 1) << 5); R = (st >> 1) * 16 + swz / 64; C = (st & 1) * 32 + (swz % 64) / 2; }
__host__ __device__ __forceinline__ int perm32(int rho) { const int n = rho >> 4, i = rho & 15; return 8 * (i >> 2) + 4 * n + (i & 3); }

struct Unit { int pm, pn, k0, nt, parts, tile; };
struct Gemm { const bf16_t* A; const bf16_t* Bt; int M, N, K; bool tiled; };

struct StaticOrder {
    int nM, nN, nwg, G, c, ntk;
    __host__ __device__ void init(int M, int N, int K, int G_, int c_) { nM = M / BM; nN = N / BM; nwg = nM * nN; G = G_; c = c_; ntk = K / BK; }
    __host__ __device__ bool next(int i, Unit& u) const {
        const long L = (long)i * G + c; if (L >= nwg) return false;
        int wgid = (int)L; { const int q = nwg / NXCD, r = nwg % NXCD, xcd = wgid % NXCD, off = wgid / NXCD; wgid = (xcd < r ? xcd * (q + 1) : r * (q + 1) + (xcd - r) * q) + off; }
        const int nig = WGM * nN, gid = wgid / nig, fm = gid * WGM, gsz = (nM - fm) < WGM ? (nM - fm) : WGM;
        u.pm = fm + ((wgid % nig) % gsz); u.pn = (wgid % nig) / gsz; u.k0 = 0; u.nt = ntk; u.parts = 1; u.tile = 0; return true;
    }
    __device__ __forceinline__ void a_ready(const Unit&) const {}
    __device__ __forceinline__ void done(const Unit&) const {}
};


struct TailSplit {
    StaticOrder so, all; int v;
    __host__ __device__ void init(int M, int N, int K, int G_, int b) { so.init(64 * BM, N, K, G_, b); all.init(M, N, K, G_, b); v = (G_ % 8 == 0) ? (b % 8) * (G_ / 8) + b / 8 : b; }
    __host__ __device__ bool split() const { return all.G == 256 && all.nwg == 320; }
    __host__ __device__ bool next(int i, Unit& u) const {
        if (!split()) return all.next(i, u);
        if (i == 0) return so.next(0, u);
        if (i > 1) return false;
        const int tidx = v >> 2, part = v & 3, q = so.ntk / 4, rem = so.ntk - 4 * q;
        int k0, nt;
        if ((q & 1) == 0) { nt = q + ((rem == 2 && part == 0) ? 2 : 0); k0 = part * q + ((rem == 2 && part > 0) ? 2 : 0); }
        else { const int a = q + 1, b2 = q - 1 + rem; nt = part < 2 ? a : b2; k0 = part < 2 ? part * a : 2 * a + (part - 2) * b2; }
        u.pm = 64 + (tidx >> 2); u.pn = tidx & 3; u.k0 = k0; u.nt = nt; u.parts = 4; u.tile = tidx * 4 + part; return true;
    }
    __device__ __forceinline__ void a_ready(const Unit&) const {}
    __device__ __forceinline__ void done(const Unit&) const {}
};
struct EpiBf16 {
    static constexpr bool PERM = true, AFTER_DRAIN = false;
    bf16_t* O; int ldc;
    __device__ __forceinline__ void operator()(const f32x4 (&acc)[2][2][4][2], const Unit& u, int wr, int wc, int fr, int fq) const {
        const int row0 = u.pm * BM + wr * 64 + fr; const int col0 = u.pn * BM + wc * 32 + 8 * fq;
#pragma unroll
        for (int ai = 0; ai < 2; ++ai)
#pragma unroll
            for (int m = 0; m < 4; ++m) { bf16_t* rowp = O + (size_t)(row0 + ai * HALF + m * 16) * ldc + col0;
#pragma unroll
                for (int bj = 0; bj < 2; ++bj) { const f32x4 v0 = acc[ai][bj][m][0], v1 = acc[ai][bj][m][1];
                    u32x4 w; w.x = ::pk2(v0[0], v0[1]); w.y = ::pk2(v0[2], v0[3]); w.z = ::pk2(v1[0], v1[1]); w.w = ::pk2(v1[2], v1[3]);
                    *(u32x4*)(rowp + bj * HALF) = w; } }
    }
};
struct EpiOddIn {
    static constexpr bool PERM = true, AFTER_DRAIN = false;
    bf16_t* O; unsigned char* ws; float* outp; const LAS float* rtl;
    __device__ __forceinline__ void operator()(const f32x4 (&acc)[2][2][4][2], const Unit& u, int wr, int wc, int fr, int fq) const {
        if (u.pn < 4) {
            const int row0 = u.pm * BM + wr * 64 + fr; const int col0 = u.pn * BM + wc * 32 + 8 * fq;
#pragma unroll
            for (int ai = 0; ai < 2; ++ai)
#pragma unroll
                for (int m = 0; m < 4; ++m) { bf16_t* rowp = O + (size_t)(row0 + ai * HALF + m * 16) * ::ODN + col0;
#pragma unroll
                    for (int bj = 0; bj < 2; ++bj) { const f32x4 v0 = acc[ai][bj][m][0], v1 = acc[ai][bj][m][1];
                        u32x4 w; w.x = ::pk2(v0[0], v0[1]); w.y = ::pk2(v0[2], v0[3]); w.z = ::pk2(v1[0], v1[1]); w.w = ::pk2(v1[2], v1[3]);
                        *(u32x4*)(rowp + bj * HALF) = w; } }
            return;
        }
        const bool isk = (u.pn == 4), lat = u.pm >= 16;
        const int b = lat ? (u.pm - 16) >> 4 : u.pm, tbase = lat ? ((u.pm - 16) & 15) * 256 : 0;
        bf16_t* dstb = lat ? (bf16_t*)(ws + (isk ? ::WS_KL : ::WS_VL)) + ((size_t)b * 4608 + 512 + tbase) * 256 : (bf16_t*)(ws + (isk ? ::WS_KP : ::WS_VP)) + (size_t)b * 256 * 256;
        float* fo = outp + (isk ? ::OUT_CK : ::OUT_CV) + (size_t)u.pm * 256 * 256;
        const int c0k = 64 * wc + 8 * fq, c0v = 32 * wc + 8 * fq;
#pragma unroll
        for (int ai = 0; ai < 2; ++ai)
#pragma unroll
            for (int m = 0; m < 4; ++m) {
                const int rowloc = ai * HALF + wr * 64 + m * 16 + fr, t = tbase + rowloc;
                f32x4 y[2][2];
#pragma unroll
                for (int bj = 0; bj < 2; ++bj)
#pragma unroll
                    for (int n = 0; n < 2; ++n) y[bj][n] = acc[ai][bj][m][n];
                if (isk) {
                    float ss = 0.f;
#pragma unroll
                    for (int bj = 0; bj < 2; ++bj)
#pragma unroll
                        for (int n = 0; n < 2; ++n) ss += (y[bj][n][0] * y[bj][n][0] + y[bj][n][1] * y[bj][n][1]) + (y[bj][n][2] * y[bj][n][2] + y[bj][n][3] * y[bj][n][3]);
                    { auto r = __builtin_amdgcn_permlane16_swap(__float_as_uint(ss), __float_as_uint(ss), false, false); ss = __uint_as_float(r[0]) + __uint_as_float(r[1]); }
                    { auto r = __builtin_amdgcn_permlane32_swap(__float_as_uint(ss), __float_as_uint(ss), false, false); ss = __uint_as_float(r[0]) + __uint_as_float(r[1]); }
                    const float rs = 1.0f / sqrtf(ss * (1.f / 64.f) + ::EPS);
#pragma unroll
                    for (int bj = 0; bj < 2; ++bj)
#pragma unroll
                        for (int n = 0; n < 2; ++n) y[bj][n] = y[bj][n] * rs * *(const LAS f32x4*)(rtl + 2048 + 32 * bj + 8 * fq + 4 * n);
                    if (lat) {
#pragma unroll
                        for (int bj = 0; bj < 2; ++bj) { const int posr = bj ? (t & 63) : (t >> 6);
#pragma unroll
                            for (int n = 0; n < 2; ++n) { const LAS f32x4* c4 = (const LAS f32x4*)(rtl + (posr * 16 + 8 * (fq & 1) + 4 * n) * 2);
                                const f32x4 cs0 = c4[0], cs1 = c4[1];
                                const float cc[4] = {cs0.x, cs0.z, cs1.x, cs1.z}, sn[4] = {cs0.y, cs0.w, cs1.y, cs1.w};
#pragma unroll
                                for (int e = 0; e < 4; ++e) { const float yv = y[bj][n][e];
                                    auto r = __builtin_amdgcn_permlane32_swap(__float_as_uint(yv), __float_as_uint(yv), false, false);
                                    const float o = (fq & 2) ? __uint_as_float(r[0]) : __uint_as_float(r[1]);
                                    y[bj][n][e] = (fq & 2) ? yv * cc[e] + o * sn[e] : yv * cc[e] - o * sn[e]; } } }
                    }
                }
#pragma unroll
                for (int bj = 0; bj < 2; ++bj) { const int col = isk ? c0k + 32 * bj : c0v + 128 * bj;
                    u32x4 w; w.x = ::pk2(y[bj][0][0], y[bj][0][1]); w.y = ::pk2(y[bj][0][2], y[bj][0][3]); w.z = ::pk2(y[bj][1][0], y[bj][1][1]); w.w = ::pk2(y[bj][1][2], y[bj][1][3]);
                    *(u32x4*)(dstb + (size_t)rowloc * 256 + col) = w;
                    if (!lat) { float* od = fo + (size_t)rowloc * 256 + col; *(f32x4*)od = y[bj][0]; *(f32x4*)(od + 4) = y[bj][1]; } }
            }
    }
};
struct EpiSwiGLU {
    static constexpr bool PERM = true, AFTER_DRAIN = false;
    bf16_t* O; int ldc;
    static __device__ __forceinline__ unsigned sg2(float a0, float a1, float b0, float b1) {
        const f32x2 av = {a0, a1}, bv = {b0, b1};
        const f32x2 den = (f32x2){__builtin_amdgcn_exp2f(a0), __builtin_amdgcn_exp2f(a1)} + 1.f;
        const f32x2 o = av * bv * (f32x2){__builtin_amdgcn_rcpf(den.x), __builtin_amdgcn_rcpf(den.y)};
        return ::pk2(o.x, o.y); }
    __device__ __forceinline__ void operator()(const f32x4 (&acc)[2][2][4][2], const Unit& u, int wr, int wc, int fr, int fq) const {
        const int col0 = u.pn * HALF + wc * 32 + 8 * fq;
        bf16_t* base = O + ((size_t)u.pm * (ldc / 64) + (col0 >> 6)) * (BM * 64) + (col0 & 63);
#pragma unroll
        for (int ai = 0; ai < 2; ++ai)
#pragma unroll
            for (int m = 0; m < 4; ++m) { bf16_t* rowp = base + (size_t)(wr * 64 + fr + ai * HALF + m * 16) * 64;
                const f32x4 a0 = acc[ai][0][m][0], a1 = acc[ai][0][m][1], b0 = acc[ai][1][m][0], b1 = acc[ai][1][m][1];
                u32x4 w; w.x = sg2(a0[0], a0[1], b0[0], b0[1]); w.y = sg2(a0[2], a0[3], b0[2], b0[3]); w.z = sg2(a1[0], a1[1], b1[0], b1[1]); w.w = sg2(a1[2], a1[3], b1[2], b1[3]);
                *(u32x4*)rowp = w; }
    }
};
struct EpiResid {
    static constexpr bool PERM = false, AFTER_DRAIN = false;
    const float* baseP; const float* baseS; float* out; const float* modl; bf16_t* slab; int gidx; float s;
    __device__ __forceinline__ void operator()(const f32x4 (&acc)[2][2][4][2], const Unit& u, int wr, int wc, int fr, int fq) const {
        if (u.parts > 1) {
            bf16_t* sl = slab + (size_t)u.tile * 65536;
#pragma unroll
            for (int ai = 0; ai < 2; ++ai)
#pragma unroll
                for (int m = 0; m < 4; ++m) { bf16_t* rp = sl + (ai * HALF + wr * 64 + m * 16 + fr) * 256 + wc * 32 + 4 * fq;
#pragma unroll
                    for (int bj = 0; bj < 2; ++bj)
#pragma unroll
                        for (int n = 0; n < 2; ++n) { const f32x4 a = acc[ai][bj][m][n]; *(u32x2*)(rp + bj * HALF + n * 16) = (u32x2){::pk2(a[0], a[1]), ::pk2(a[2], a[3])}; } }
            return;
        }
        const int mi = u.pm < 16 ? 0 : 1 + ((u.pm - 16) >> 4);
        const float* gate = modl + (size_t)(mi * 9 + gidx) * 1024;
        const float* base = u.pm < 16 ? baseP + (size_t)u.pm * BM * 1024 : baseS + (size_t)(u.pm - 16) * BM * 1024;
        float* o = out + (size_t)u.pm * BM * 1024;
        const int col0 = u.pn * BM + wc * 32 + 4 * fq;
        constexpr int DEPTH = 4;
        f32x4 gv[4];
#pragma unroll
        for (int q = 0; q < 4; ++q) gv[q] = *(const f32x4*)(gate + col0 + (q >> 1) * HALF + (q & 1) * 16);
        const size_t off0 = (size_t)(wr * 64 + fr) * 1024 + col0;
        f32x4 bs[DEPTH][4];
#define RESID_LD(it) _Pragma("unroll") for (int q = 0; q < 4; ++q) bs[(it) % DEPTH][q] = *(const f32x4*)(base + off0 + (size_t)(((it) >> 2) * HALF + ((it) & 3) * 16) * 1024 + (q >> 1) * HALF + (q & 1) * 16)
#pragma unroll
        for (int it = 0; it < DEPTH; ++it) { RESID_LD(it); }
        asm volatile("" : "+v"(gv[0]), "+v"(gv[1]), "+v"(gv[2]), "+v"(gv[3]) :: "memory");
#pragma unroll
        for (int q = 0; q < 4; ++q) gv[q] = gv[q] * s;
#pragma unroll
        for (int it = 0; it < 8; ++it) {
#pragma unroll
            for (int q = 0; q < 4; ++q) *(f32x4*)(o + off0 + (size_t)((it >> 2) * HALF + (it & 3) * 16) * 1024 + (q >> 1) * HALF + (q & 1) * 16) = bs[it % DEPTH][q] + gv[q] * acc[it >> 2][q >> 1][it & 3][q & 1];
            asm volatile("" ::: "memory");
            if (it + DEPTH < 8) { RESID_LD(it + DEPTH); asm volatile("" ::: "memory"); }
        }
#undef RESID_LD
    }
};
template <class Epi, class Sched, bool ALIGN_EPI = false, bool SP2 = false>
__device__ __forceinline__ void gemm_phase(PG8_LAS unsigned char* lds, const Gemm g, const Sched& S, const Epi& E, const int wid_in) {
    const int wid = wid_in, lane = ::fresh_lane(), tid = wid * 64 + lane, wr = wid >> 2, wc = wid & 3, fr = lane & 15, fq = lane >> 4;
    const int K = g.K;
    unsigned voffA[2], voffB[2];
#pragma unroll
    for (int i = 0; i < 2; ++i) { int R, C; stage_rc(tid * 16 + i * 8192, R, C); const int Rb = Epi::PERM ? ((R & ~31) + perm32(R & 31)) : R;
        const int ld = g.tiled ? BK : K;
        voffA[i] = (unsigned)(R * ld + C) * 2u; voffB[i] = (unsigned)(Rb * ld + C) * 2u; }
    const size_t kstep = g.tiled ? (size_t)(BM * BK * 2) : (size_t)(BK * 2);
    const size_t hstep = g.tiled ? (size_t)(HALF * BK * 2) : (size_t)HALF * K * 2;
    const size_t tstep = (size_t)BM * K * 2;
    const unsigned ldsw = (unsigned)wid * 1024u;
    const int aoff = lds_byte(wr * 64 + fr, fq * 8), boff = lds_byte(wc * 32 + fr, fq * 8);
#define PG8_SA(b, h) (((b) * 2 + (h)) * HTB)
#define PG8_SB(b, h) ((4 + (b) * 2 + (h)) * HTB)
#define PG8_STAGE(bufoff, gbase, voff) do { _Pragma("unroll") for (int _i = 0; _i < 2; ++_i) \
        __builtin_amdgcn_global_load_lds((const unsigned*)((const char*)(gbase) + (voff)[_i]), (PG8_LAS unsigned*)(lds + (bufoff) + ldsw + _i * 8192), 16, 0, 0); } while (0)
#define PG8_LDA(dst, b, h) do { _Pragma("unroll") for (int m = 0; m < 4; ++m) _Pragma("unroll") for (int k = 0; k < 2; ++k) dst[m][k] = *(const PG8_LAS bf16x8*)(lds + PG8_SA(b, h) + aoff + m * 2048 + k * 1024); } while (0)
#define PG8_LDB(dst, b, h) do { _Pragma("unroll") for (int n = 0; n < 2; ++n) _Pragma("unroll") for (int k = 0; k < 2; ++k) dst[n][k] = *(const PG8_LAS bf16x8*)(lds + PG8_SB(b, h) + boff + n * 2048 + k * 1024); } while (0)
#define PG8_MMA(ai, bj, At, Bt) do { __builtin_amdgcn_s_setprio(1); _Pragma("unroll") for (int m = 0; m < 4; ++m) _Pragma("unroll") for (int n = 0; n < 2; ++n) _Pragma("unroll") for (int k = 0; k < 2; ++k) \
        acc[ai][bj][m][n] = __builtin_amdgcn_mfma_f32_16x16x32_bf16(Bt[n][k], At[m][k], acc[ai][bj][m][n], 0, 0, 0); __builtin_amdgcn_s_setprio(0); } while (0)
#define PG8_WAIT_V(n) asm volatile("s_waitcnt vmcnt(" #n ")" ::: "memory")
#define PG8_WAIT_L(n) asm volatile("s_waitcnt lgkmcnt(" #n ")" ::: "memory")
#define PG8_BAR __builtin_amdgcn_s_barrier()
#define PG8_SCHED __builtin_amdgcn_sched_barrier(0)
    Unit cur, nxt; int ui = 0;
    if (!S.next(0, cur)) return;
    f32x4 acc[2][2][4][2];
#pragma unroll
    for (int a = 0; a < 2; ++a)
#pragma unroll
        for (int b = 0; b < 2; ++b)
#pragma unroll
            for (int m = 0; m < 4; ++m)
#pragma unroll
                for (int n = 0; n < 2; ++n) acc[a][b][m][n] = (f32x4){0.f, 0.f, 0.f, 0.f};
    bf16x8 At[4][2], B0[2][2], B1[2][2];
    const char* cA = (const char*)g.A + (size_t)cur.pm * tstep + (size_t)cur.k0 * kstep; const char* cB = (const char*)g.Bt + (size_t)cur.pn * tstep + (size_t)cur.k0 * kstep;
    S.a_ready(cur);
    if constexpr (SP2) {
        PG8_STAGE(PG8_SB(0, 0), cB, voffB); PG8_STAGE(PG8_SB(0, 1), cB + hstep, voffB); PG8_STAGE(PG8_SA(0, 0), cA, voffA); PG8_STAGE(PG8_SA(0, 1), cA + hstep, voffA);
        if (wr == 1) PG8_BAR;
        PG8_WAIT_V(2); PG8_BAR;
        PG8_STAGE(PG8_SB(1, 0), cB + kstep, voffB); PG8_STAGE(PG8_SA(1, 0), cA + kstep, voffA); PG8_STAGE(PG8_SB(1, 1), cB + hstep + kstep, voffB);
        PG8_WAIT_V(6); PG8_BAR;
    } else {
        PG8_STAGE(PG8_SB(0, 0), cB, voffB); PG8_STAGE(PG8_SA(0, 0), cA, voffA); PG8_STAGE(PG8_SB(0, 1), cB + hstep, voffB); PG8_STAGE(PG8_SA(0, 1), cA + hstep, voffA);
        if (wr == 1) PG8_BAR;
        PG8_WAIT_V(4); PG8_BAR;
        PG8_STAGE(PG8_SB(1, 0), cB + kstep, voffB); PG8_STAGE(PG8_SA(1, 0), cA + kstep, voffA); PG8_STAGE(PG8_SB(1, 1), cB + hstep + kstep, voffB);
        PG8_WAIT_V(6); PG8_BAR;
    }
    for (;;) {
        const bool has_next = S.next(ui + 1, nxt);
        const char* nA = has_next ? (const char*)g.A + (size_t)nxt.pm * tstep + (size_t)nxt.k0 * kstep : cA; const char* nB = has_next ? (const char*)g.Bt + (size_t)nxt.pn * tstep + (size_t)nxt.k0 * kstep : cB;
        const int nt = cur.nt;
        for (int t = 0; t < nt; t += 2) {
            const bool last = (t == nt - 2);
            const char* a1 = cA + (size_t)(t + 1) * kstep;
            const char* a2 = last ? nA : cA + (size_t)(t + 2) * kstep; const char* b2 = last ? nB : cB + (size_t)(t + 2) * kstep;
            const char* a3 = a2 + kstep; const char* b3 = b2 + kstep;
            if (last && has_next) S.a_ready(nxt);
            if constexpr (SP2) {
            PG8_LDB(B0, 0, 0); PG8_LDB(B1, 0, 1); PG8_SCHED; PG8_LDA(At, 0, 0); PG8_STAGE(PG8_SA(1, 1), a1 + hstep, voffA);
            PG8_WAIT_V(8); PG8_WAIT_L(0); PG8_BAR; PG8_MMA(0, 0, At, B0); PG8_MMA(0, 1, At, B1); PG8_BAR; PG8_SCHED;
            PG8_LDA(At, 0, 1); PG8_STAGE(PG8_SB(0, 0), b2, voffB); PG8_STAGE(PG8_SB(0, 1), b2 + hstep, voffB); PG8_STAGE(PG8_SA(0, 0), a2, voffA);
            PG8_WAIT_V(8); PG8_WAIT_L(0); PG8_BAR; PG8_MMA(1, 0, At, B0); PG8_MMA(1, 1, At, B1); PG8_BAR; PG8_SCHED;
            PG8_LDB(B0, 1, 0); PG8_LDB(B1, 1, 1); PG8_SCHED; PG8_LDA(At, 1, 0); PG8_STAGE(PG8_SA(0, 1), a2 + hstep, voffA);
            PG8_WAIT_V(8); PG8_WAIT_L(0); PG8_BAR; PG8_MMA(0, 0, At, B0); PG8_MMA(0, 1, At, B1); PG8_BAR; PG8_SCHED;
            PG8_LDA(At, 1, 1); PG8_STAGE(PG8_SB(1, 0), b3, voffB); PG8_STAGE(PG8_SB(1, 1), b3 + hstep, voffB); PG8_STAGE(PG8_SA(1, 0), a3, voffA);
            PG8_WAIT_V(8); PG8_WAIT_L(0); PG8_BAR; PG8_MMA(1, 0, At, B0); PG8_MMA(1, 1, At, B1); PG8_BAR; PG8_SCHED;
            } else {
            PG8_LDB(B0, 0, 0); PG8_SCHED; PG8_LDA(At, 0, 0); PG8_STAGE(PG8_SA(1, 1), a1 + hstep, voffA);
            PG8_WAIT_L(8); PG8_BAR; PG8_WAIT_L(0); PG8_MMA(0, 0, At, B0); PG8_BAR; PG8_SCHED;
            PG8_LDB(B1, 0, 1); PG8_STAGE(PG8_SB(0, 0), b2, voffB);
            PG8_BAR; PG8_WAIT_L(0); PG8_MMA(0, 1, At, B1); PG8_BAR;
            PG8_LDA(At, 0, 1); PG8_STAGE(PG8_SA(0, 0), a2, voffA);
            PG8_BAR; PG8_WAIT_L(0); PG8_MMA(1, 0, At, B0); PG8_BAR; PG8_SCHED;
            PG8_STAGE(PG8_SB(0, 1), b2 + hstep, voffB);
            PG8_WAIT_V(6); PG8_BAR; PG8_MMA(1, 1, At, B1); PG8_BAR;
            PG8_LDB(B0, 1, 0); PG8_SCHED; PG8_LDA(At, 1, 0); PG8_STAGE(PG8_SA(0, 1), a2 + hstep, voffA);
            PG8_WAIT_L(8); PG8_BAR; PG8_WAIT_L(0); PG8_MMA(0, 0, At, B0); PG8_BAR; PG8_SCHED;
            PG8_LDB(B1, 1, 1); PG8_STAGE(PG8_SB(1, 0), b3, voffB);
            PG8_BAR; PG8_WAIT_L(0); PG8_MMA(0, 1, At, B1); PG8_BAR;
            PG8_LDA(At, 1, 1); PG8_STAGE(PG8_SA(1, 0), a3, voffA);
            PG8_BAR; PG8_WAIT_L(0); PG8_MMA(1, 0, At, B0); PG8_BAR; PG8_SCHED;
            PG8_STAGE(PG8_SB(1, 1), b3 + hstep, voffB);
            PG8_WAIT_V(6); PG8_BAR; PG8_MMA(1, 1, At, B1); PG8_BAR;
            }
        }
        if constexpr (ALIGN_EPI) { if (wr == 0) PG8_BAR; }
        if constexpr (!Epi::AFTER_DRAIN) { E(acc, cur, wr, wc, fr, fq); S.done(cur); }
        if (!has_next) break;
#pragma unroll
        for (int a = 0; a < 2; ++a)
#pragma unroll
            for (int b = 0; b < 2; ++b)
#pragma unroll
                for (int m = 0; m < 4; ++m)
#pragma unroll
                    for (int n = 0; n < 2; ++n) acc[a][b][m][n] = (f32x4){0.f, 0.f, 0.f, 0.f};
        cur = nxt; cA = nA; cB = nB; ++ui;
        if constexpr (ALIGN_EPI) { if (wr == 1) PG8_BAR; }
    }
    PG8_WAIT_V(0);
    if constexpr (!ALIGN_EPI) { if (wr == 0) PG8_BAR; }
    PG8_BAR;
    if constexpr (Epi::AFTER_DRAIN) { E.fused(acc, cur, wr, wc, fr, fq, lds, wid, lane); S.done(cur); }
#undef PG8_SA
#undef PG8_SB
#undef PG8_STAGE
#undef PG8_LDA
#undef PG8_LDB
#undef PG8_MMA
#undef PG8_WAIT_V
#undef PG8_WAIT_L
#undef PG8_BAR
#undef PG8_SCHED
}
}
namespace attn_body {
using bf16=__hip_bfloat16;
using bf16x8=__attribute__((ext_vector_type(8)))short;
using s16x4=__attribute__((ext_vector_type(4)))short;
using f32x16=__attribute__((ext_vector_type(16)))float;
using u32x4=__attribute__((ext_vector_type(4)))unsigned;
constexpr int D=64,QP=1024,KVP=256,QSP=1536;
constexpr int NW=8,QBLK=32,QB=QBLK*NW,KVBLK=64;
constexpr int ATTN_UNIT_ROWS=QB;
__device__ __forceinline__ int crow(int r,int hi){return (r&3)+8*(r>>2)+4*hi;}
#define SBAR() __builtin_amdgcn_sched_barrier(0)
constexpr int NSLOT=3, SLOTB=8192;
constexpr int LDS_K=0, LDS_V=NSLOT*SLOTB, LDS_WS=2*NSLOT*SLOTB, LDS_OST=LDS_WS+NW*64*4, LDS_BYTES=LDS_OST+NW*4096;
constexpr float C2=0.125f*1.4426950408889634f;
__device__ __forceinline__ void glds16(const void*gsrc,unsigned lds_dst){unsigned keep;
  asm volatile("s_mov_b32 %0, m0\n\ts_mov_b32 m0, %2\n\ts_nop 0\n\tglobal_load_lds_dwordx4 %1, off\n\ts_mov_b32 m0, %0":"=&s"(keep):"v"(gsrc),"s"(lds_dst):"memory");}
__device__ __forceinline__ float max3f(float a,float b,float c){float r;asm("v_max3_f32 %0, %1, %2, %3":"=v"(r):"v"(a),"v"(b),"v"(c));return r;}
__device__ __forceinline__ float max2f(float a,float b){float r;asm("v_max_f32_e32 %0, %1, %2":"=v"(r):"v"(a),"v"(b));return r;}
__device__ __forceinline__ float fadd_s(float a,float b){float r;asm("v_add_f32_e32 %0, %1, %2":"=v"(r):"v"(a),"v"(b));return r;}
__device__ __forceinline__ float fsub_s(float a,float b){float r;asm("v_sub_f32_e32 %0, %1, %2":"=v"(r):"v"(a),"v"(b));return r;}
typedef float f32x2_t __attribute__((ext_vector_type(2))); typedef __bf16 bf16x2_t __attribute__((ext_vector_type(2)));
__device__ __forceinline__ unsigned cvtpk_s(float lo,float hi){f32x2_t v={lo,hi};bf16x2_t b=__builtin_convertvector(v,bf16x2_t);return __builtin_bit_cast(unsigned,b);}
#define WAIT_BAR(N) asm volatile("s_waitcnt vmcnt(" #N ") lgkmcnt(0)\n\ts_barrier":::"memory")

__device__ __forceinline__ void qkt(f32x16&p0,f32x16&p1,const char*Kslot,const bf16x8*qr,const f32x16&negm,int r32,int hi){
  const char*kb=Kslot+hi*1024+r32*16;
  #pragma unroll
  for(int d0=0;d0<4;++d0){
    const bf16x8 b0=*reinterpret_cast<const bf16x8*>(kb+d0*2048);
    const bf16x8 b1=*reinterpret_cast<const bf16x8*>(kb+d0*2048+512);
    if(d0==0){p0=__builtin_amdgcn_mfma_f32_32x32x16_bf16(b0,qr[0],negm,0,0,0);p1=__builtin_amdgcn_mfma_f32_32x32x16_bf16(b1,qr[0],negm,0,0,0);}
    else{p0=__builtin_amdgcn_mfma_f32_32x32x16_bf16(b0,qr[d0],p0,0,0,0);p1=__builtin_amdgcn_mfma_f32_32x32x16_bf16(b1,qr[d0],p1,0,0,0);}}
}
typedef __attribute__((address_space(3))) const char* lds_cptr;
typedef short v4i16_t __attribute__((ext_vector_type(4)));
__device__ __forceinline__ void kload8(bf16x8*kf,lds_cptr kp){
  kf[0]=*(const __attribute__((address_space(3))) bf16x8*)(kp);      kf[1]=*(const __attribute__((address_space(3))) bf16x8*)(kp+512);
  kf[2]=*(const __attribute__((address_space(3))) bf16x8*)(kp+2048); kf[3]=*(const __attribute__((address_space(3))) bf16x8*)(kp+2560);
  kf[4]=*(const __attribute__((address_space(3))) bf16x8*)(kp+4096); kf[5]=*(const __attribute__((address_space(3))) bf16x8*)(kp+4608);
  kf[6]=*(const __attribute__((address_space(3))) bf16x8*)(kp+6144); kf[7]=*(const __attribute__((address_space(3))) bf16x8*)(kp+6656);
}
__device__ __forceinline__ void kload2(bf16x8*kf,lds_cptr kp,int j){ kf[2*j]=*(const __attribute__((address_space(3))) bf16x8*)(kp+j*2048); kf[2*j+1]=*(const __attribute__((address_space(3))) bf16x8*)(kp+j*2048+512); }
__device__ __forceinline__ s16x4 vtr(lds_cptr p){ return __builtin_bit_cast(s16x4,__builtin_amdgcn_ds_read_tr16_b64_v4i16((__attribute__((address_space(3))) v4i16_t*)p)); }
__device__ __forceinline__ float rowmax(const f32x16&p0,const f32x16&p1){
  float a=max3f(p0[0],p0[1],p1[0]),b=max3f(p0[2],p0[3],p1[1]);a=max3f(a,p1[2],p1[3]);
  #pragma unroll
  for(int r=4;r<16;r+=4){a=max3f(a,p0[r],p0[r+1]);b=max3f(b,p0[r+2],p0[r+3]);a=max3f(a,p1[r],p1[r+1]);b=max3f(b,p1[r+2],p1[r+3]);}
  const float m=max2f(a,b);
  auto rr=__builtin_amdgcn_permlane32_swap(__float_as_uint(m),__float_as_uint(m),false,false);
  return max2f(__uint_as_float(rr[0]),__uint_as_float(rr[1]));
}
__device__ __forceinline__ void pv(f32x16*o,int vb,bf16x8 pa0,bf16x8 pa1,bf16x8 pa2,bf16x8 pa3){
  #pragma unroll
  for(int d0=0;d0<2;++d0){s16x4 lo[4],hi[4];
    #pragma unroll
    for(int ks=0;ks<4;++ks){
      asm volatile("ds_read_b64_tr_b16 %0,%1 offset:%c2":"=&v"(lo[ks]):"v"(vb),"i"(d0*4096+ks*1024):"memory");
      asm volatile("ds_read_b64_tr_b16 %0,%1 offset:%c2":"=&v"(hi[ks]):"v"(vb),"i"(d0*4096+ks*1024+512):"memory");}
    asm volatile("s_waitcnt lgkmcnt(0)":::"memory");SBAR();
    #define PK(k) (bf16x8){lo[k][0],lo[k][1],lo[k][2],lo[k][3],hi[k][0],hi[k][1],hi[k][2],hi[k][3]}
    o[d0]=__builtin_amdgcn_mfma_f32_32x32x16_bf16(pa0,PK(0),o[d0],0,0,0);
    o[d0]=__builtin_amdgcn_mfma_f32_32x32x16_bf16(pa1,PK(1),o[d0],0,0,0);
    o[d0]=__builtin_amdgcn_mfma_f32_32x32x16_bf16(pa2,PK(2),o[d0],0,0,0);
    o[d0]=__builtin_amdgcn_mfma_f32_32x32x16_bf16(pa3,PK(3),o[d0],0,0,0);
    #undef PK
  }
}

#ifndef ATTN_STORE16
#define ATTN_STORE16(p,v) (*(u32x4*)(p)=(v))
#endif
template<int THRL> __device__ __forceinline__ void attn_unit(const bf16*Q0,const bf16*__restrict__ Kh,const bf16*__restrict__ Vh,bf16*O0,const int NT,char*shm,const int wid,const float*qnw,const float*rope,const int tpos){
  const int lane=::fresh_lane(),tid=wid*64+lane,r32=lane&31,hi=lane>>5;
  const bf16*Qw=Q0+(long)(wid*QBLK)*QSP;
  const unsigned lds0=(unsigned)(uintptr_t)shm;
  float*wsf=(float*)(shm+LDS_WS)+wid*64;
  const bf16*ksrc=Kh+(long)lane*KVP+wid*8;
  const bf16*vsrc=Vh+(long)(16*(wid&3)+(lane>>2))*KVP+(wid>>2)*32+(lane&3)*8;
  const unsigned kdst=lds0+LDS_K+wid*1024, vdst=lds0+LDS_V+wid*1024;
  #define DMA_K(t,slot) glds16(ksrc+(long)(t)*KVBLK*KVP,(unsigned)__builtin_amdgcn_readfirstlane(kdst+(slot)))
  #define DMA_V(t,slot) glds16(vsrc+(long)(t)*KVBLK*KVP,(unsigned)__builtin_amdgcn_readfirstlane(vdst+(slot)))
  const int vb0=(int)(lds0+LDS_V)+((lane>>4)&1)*32+(lane&3)*8+(4*hi+((lane&15)>>2))*64;
  const char*Kbase=shm+LDS_K; bf16x8 kf[8];
  const lds_cptr shm3=(lds_cptr)shm; const lds_cptr kp0=shm3+LDS_K+hi*1024+r32*16; const lds_cptr vp0=shm3+LDS_V+((lane>>4)&1)*32+(lane&3)*8+(4*hi+((lane&15)>>2))*64;
  DMA_K(0,0);DMA_V(0,0);DMA_K(1,SLOTB);
  bf16x8 qr[4];
  { float x[4][8]; float ss=0.f;
    #pragma unroll
    for(int d0=0;d0<4;++d0){ const u32x4 raw=*reinterpret_cast<const u32x4*>(&Qw[(long)r32*QSP+d0*16+hi*8]);
      x[d0][0]=__uint_as_float(raw.x<<16);x[d0][1]=__uint_as_float(raw.x&0xffff0000u);x[d0][2]=__uint_as_float(raw.y<<16);x[d0][3]=__uint_as_float(raw.y&0xffff0000u);
      x[d0][4]=__uint_as_float(raw.z<<16);x[d0][5]=__uint_as_float(raw.z&0xffff0000u);x[d0][6]=__uint_as_float(raw.w<<16);x[d0][7]=__uint_as_float(raw.w&0xffff0000u);
      #pragma unroll
      for(int e=0;e<8;++e)ss+=x[d0][e]*x[d0][e]; }
    { auto rr=__builtin_amdgcn_permlane32_swap(__float_as_uint(ss),__float_as_uint(ss),false,false); ss=__uint_as_float(rr[0])+__uint_as_float(rr[1]); }
    const float rs=C2/sqrtf(ss*(1.f/64.f)+1e-6f);
    #pragma unroll
    for(int d0=0;d0<4;++d0){ const float*wq=qnw+d0*16+hi*8;
      #pragma unroll
      for(int e=0;e<8;++e)x[d0][e]*=rs*wq[e]; }
    if(tpos>=0){ const int t=tpos+wid*QBLK+r32; const float*cr=rope+(size_t)((t>>6)*16+8*hi)*2,*cc=rope+(size_t)((t&63)*16+8*hi)*2;
      #pragma unroll
      for(int e=0;e<8;++e){ const float c1=cr[2*e],s1=cr[2*e+1],c2=cc[2*e],s2=cc[2*e+1];
        const float a0=x[0][e],a1=x[1][e],b0=x[2][e],b1=x[3][e];
        x[0][e]=a0*c1-a1*s1; x[1][e]=a1*c1+a0*s1; x[2][e]=b0*c2-b1*s2; x[3][e]=b1*c2+b0*s2; } }
    #pragma unroll
    for(int d0=0;d0<4;++d0){ u32x4 w; w.x=cvtpk_s(x[d0][0],x[d0][1]); w.y=cvtpk_s(x[d0][2],x[d0][3]); w.z=cvtpk_s(x[d0][4],x[d0][5]); w.w=cvtpk_s(x[d0][6],x[d0][7]); qr[d0]=__builtin_bit_cast(bf16x8,w); } }
  float mhat=0.f,l_reg=0.f;f32x16 o[2],negm;{float z_;asm volatile("v_mov_b32 %0, 0":"=v"(z_)); _Pragma("unroll") for(int r=0;r<16;++r){o[0][r]=z_;o[1][r]=z_;negm[r]=z_;}} asm volatile("":"+v"(negm));
  #define CMASK(P0,P1,t) do{}while(0)
  bool resc=false;
  #define START(P0,P1) do{ const float rm=rowmax(P0,P1); resc=false; \
    { const float dl=rm; mhat=fadd_s(mhat,dl); \
      _Pragma("unroll") for(int r=0;r<16;++r){P0[r]=fsub_s(P0[r],dl);P1[r]=fsub_s(P1[r],dl);} \
      _Pragma("unroll") for(int r=0;r<16;++r)negm[r]=-mhat; asm volatile("":"+v"(negm)); } \
    _Pragma("unroll") for(int r=0;r<16;++r)P0[r]=__builtin_amdgcn_exp2f(P0[r]); }while(0)
  #define RESC() do{ if(resc){ asm volatile("s_waitcnt lgkmcnt(0)":::"memory"); \
      _Pragma("unroll") for(int d_=0;d_<2;++d_) _Pragma("unroll") for(int r=0;r<16;++r)o[d_][r]*=wsf[crow(r,hi)]; } }while(0)
  f32x16 pA0,pA1,pB0,pB1;
  int sl_prev=0,sl_cur=0,sl_next=SLOTB;
  #define ROT() do{sl_prev=sl_cur;sl_cur=sl_next;sl_next=(sl_next==(NSLOT-1)*SLOTB)?0:sl_next+SLOTB;}while(0)
  DMA_K(2,2*SLOTB);
  WAIT_BAR(3);
  qkt(pA0,pA1,Kbase,qr,negm,r32,hi);asm volatile("s_nop 15\n\ts_nop 7":"+v"(pA0),"+v"(pA1));CMASK(pA0,pA1,0);
  START(pA0,pA1);
  _Pragma("unroll") for(int r=0;r<16;++r)pA1[r]=__builtin_amdgcn_exp2f(pA1[r]);
  WAIT_BAR(0);
  DMA_K(3,0);DMA_V(1,SLOTB);
  ROT();
  kload8(kf,kp0+sl_cur);
  WAIT_BAR(2);
  s16x4 vlo[8],vhi[8]; u32x4 pw0,pw1,pw2,pw3;
  #define PKW(P,B) cvtpk_s(P[B],P[B+1])
  #define PAF(k) __builtin_bit_cast(bf16x8,pw##k)
  #define VFR(i) (bf16x8){vlo[i][0],vlo[i][1],vlo[i][2],vlo[i][3],vhi[i][0],vhi[i][1],vhi[i][2],vhi[i][3]}
  #define PIN(x) asm volatile("":"+v"(x))
  #define MX3(a,b,c) __builtin_fmaxf(__builtin_fmaxf((a),(b)),(c))
  #define GAPA(MF,A0,A1,A2,A3,W0,W1,PW) do{ MF; sacc+=A0; sacc+=A1; sacc+=A2; sacc+=A3; PIN(sacc); W0; W1; PIN(PW); SBAR(); }while(0)
  #define EX(v) __builtin_amdgcn_exp2f(v)
  #define GAPB(MF,X,B) do{ MF; X[B]=EX(X[B]); X[B+1]=EX(X[B+1]); X[B+2]=EX(X[B+2]); X[B+3]=EX(X[B+3]); PIN(X); SBAR(); }while(0)
  #define VRD(i) do{ vlo[i]=vtr(vp_+(((i)>>2)*4096+((i)&3)*1024)); vhi[i]=vtr(vp_+(((i)>>2)*4096+((i)&3)*1024+512)); }while(0)
  #define KRD(G,j) do{ if(G){ kload2(kf,kp0+sl_next,j); SBAR(); } }while(0)
  #define STEP(C0,C1,P0,P1,t,GK,GV,GL) do{ SBAR(); \
    const lds_cptr vp_=vp0+sl_prev; \
    VRD(0); SBAR(); float sacc=(P0[0]+P0[1]); \
    GAPA(C0=__builtin_amdgcn_mfma_f32_32x32x16_bf16(kf[0],qr[0],negm,0,0,0), P0[2],P0[3],P0[4],P0[5],     pw0[0]=PKW(P0,0), pw0[1]=PKW(P0,2), pw0); \
    VRD(4); SBAR(); GAPA(C1=__builtin_amdgcn_mfma_f32_32x32x16_bf16(kf[1],qr[0],negm,0,0,0), P0[6],P0[7],P0[8],P0[9],     pw0[2]=PKW(P0,4), pw0[3]=PKW(P0,6), pw0); \
    VRD(1); SBAR(); GAPA(C0=__builtin_amdgcn_mfma_f32_32x32x16_bf16(kf[2],qr[1],C0,0,0,0),   P0[10],P0[11],P0[12],P0[13], pw1[0]=PKW(P0,8), pw1[1]=PKW(P0,10), pw1); \
    VRD(5); SBAR(); GAPA(C1=__builtin_amdgcn_mfma_f32_32x32x16_bf16(kf[3],qr[1],C1,0,0,0),   P0[14],P0[15],P1[0],P1[1],   pw1[2]=PKW(P0,12),pw1[3]=PKW(P0,14), pw1); \
    VRD(2); SBAR(); GAPA(C0=__builtin_amdgcn_mfma_f32_32x32x16_bf16(kf[4],qr[2],C0,0,0,0),   P1[2],P1[3],P1[4],P1[5],     pw2[0]=PKW(P1,0), pw2[1]=PKW(P1,2), pw2); \
    VRD(6); SBAR(); GAPA(C1=__builtin_amdgcn_mfma_f32_32x32x16_bf16(kf[5],qr[2],C1,0,0,0),   P1[6],P1[7],P1[8],P1[9],     pw2[2]=PKW(P1,4), pw2[3]=PKW(P1,6), pw2); \
    VRD(3); SBAR(); GAPA(C0=__builtin_amdgcn_mfma_f32_32x32x16_bf16(kf[6],qr[3],C0,0,0,0),   P1[10],P1[11],P1[12],P1[13], pw3[0]=PKW(P1,8), pw3[1]=PKW(P1,10), pw3); \
    VRD(7); SBAR(); GAPA(C1=__builtin_amdgcn_mfma_f32_32x32x16_bf16(kf[7],qr[3],C1,0,0,0),   P1[14],P1[15],0.f,0.f,       pw3[2]=PKW(P1,12),pw3[3]=PKW(P1,14), pw3); \
    l_reg+=sacc; \
    if(GK){DMA_K((t)+3,sl_cur);} if(GV){DMA_V((t)+1,sl_next);} \
    CMASK(C0,C1,t); \
    { float a=MX3(C0[0],C0[1],C1[0]),b=MX3(C0[2],C0[3],C1[1]); a=MX3(a,C1[2],C1[3]); \
      _Pragma("unroll") for(int r=4;r<16;r+=4){a=MX3(a,C0[r],C0[r+1]);b=MX3(b,C0[r+2],C0[r+3]);a=MX3(a,C1[r],C1[r+1]);b=MX3(b,C1[r+2],C1[r+3]);} \
      float rm=__builtin_fmaxf(a,b); { auto rr=__builtin_amdgcn_permlane32_swap(__float_as_uint(rm),__float_as_uint(rm),false,false); rm=__builtin_fmaxf(__uint_as_float(rr[0]),__uint_as_float(rr[1])); } \
      resc=false; \
      if(__builtin_expect(__any(rm>(float)THRL),0)){ const float dl=__builtin_fmaxf(rm,0.f); mhat+=dl; \
        _Pragma("unroll") for(int r=0;r<16;++r){C0[r]-=dl;C1[r]-=dl;} \
        _Pragma("unroll") for(int r=0;r<16;++r)negm[r]=-mhat; asm volatile("":"+v"(negm)); \
        const float f=__builtin_amdgcn_exp2f(-dl); l_reg*=f; if(hi==0)wsf[r32]=f; resc=true; } } \
    SBAR(); \
    GAPB(o[0]=__builtin_amdgcn_mfma_f32_32x32x16_bf16(PAF(0),VFR(0),o[0],0,0,0), C0,0); \
    GAPB(o[1]=__builtin_amdgcn_mfma_f32_32x32x16_bf16(PAF(0),VFR(4),o[1],0,0,0), C0,4); \
    KRD(GL,0); GAPB(o[0]=__builtin_amdgcn_mfma_f32_32x32x16_bf16(PAF(1),VFR(1),o[0],0,0,0), C0,8); \
    KRD(GL,1); GAPB(o[1]=__builtin_amdgcn_mfma_f32_32x32x16_bf16(PAF(1),VFR(5),o[1],0,0,0), C0,12); \
    KRD(GL,2); GAPB(o[0]=__builtin_amdgcn_mfma_f32_32x32x16_bf16(PAF(2),VFR(2),o[0],0,0,0), C1,0); \
    KRD(GL,3); GAPB(o[1]=__builtin_amdgcn_mfma_f32_32x32x16_bf16(PAF(2),VFR(6),o[1],0,0,0), C1,4); \
    GAPB(o[0]=__builtin_amdgcn_mfma_f32_32x32x16_bf16(PAF(3),VFR(3),o[0],0,0,0), C1,8); \
    GAPB(o[1]=__builtin_amdgcn_mfma_f32_32x32x16_bf16(PAF(3),VFR(7),o[1],0,0,0), C1,12); \
    }while(0)
  int t=1;
  #undef CMASK
  #define CMASK(P0,P1,t) do{}while(0)
  for(;t+5<NT;t+=2){
    STEP(pB0,pB1,pA0,pA1,t,true,true,true);     WAIT_BAR(2); RESC(); ROT();
    STEP(pA0,pA1,pB0,pB1,t+1,true,true,true);   WAIT_BAR(2); RESC(); ROT();
  }
  #undef CMASK
  #define CMASK(P0,P1,t) do{}while(0)
  #define ENDW(tt) do{ if((tt)+3<NT){WAIT_BAR(2);} else if((tt)+2<NT){WAIT_BAR(1);} else {WAIT_BAR(0);} }while(0)
  for(;t+1<NT;t+=2){
    STEP(pB0,pB1,pA0,pA1,t,(t+3<NT),(t+1<NT),(t+1<NT));       ENDW(t);   RESC(); ROT();
    STEP(pA0,pA1,pB0,pB1,t+1,(t+4<NT),(t+2<NT),(t+2<NT));     ENDW(t+1); RESC(); ROT();
  }
  STEP(pB0,pB1,pA0,pA1,NT-1,false,false,false); RESC();
  { float sacc=pB0[0]+pB0[1]; _Pragma("unroll") for(int r=2;r<16;++r)sacc+=pB0[r]; _Pragma("unroll") for(int r=0;r<16;++r)sacc+=pB1[r]; l_reg+=sacc;
    pw0=(u32x4){PKW(pB0,0),PKW(pB0,2),PKW(pB0,4),PKW(pB0,6)};pw1=(u32x4){PKW(pB0,8),PKW(pB0,10),PKW(pB0,12),PKW(pB0,14)};pw2=(u32x4){PKW(pB1,0),PKW(pB1,2),PKW(pB1,4),PKW(pB1,6)};pw3=(u32x4){PKW(pB1,8),PKW(pB1,10),PKW(pB1,12),PKW(pB1,14)};
    SBAR(); pv(o,vb0+sl_cur,PAF(0),PAF(1),PAF(2),PAF(3)); }
  #undef PKW
  #undef PAF
  #undef VFR
  #undef PIN
  #undef MX3
  #undef GAPA
  #undef GAPB
  #undef EX
  #undef VRD
  #undef KRD
  #undef STEP
  #undef ENDW
  {auto rr=__builtin_amdgcn_permlane32_swap(__float_as_uint(l_reg),__float_as_uint(l_reg),false,false);l_reg=__uint_as_float(rr[0])+__uint_as_float(rr[1]);}
  if(hi==0)wsf[32+r32]=l_reg;asm volatile("s_waitcnt lgkmcnt(0)":::"memory");
  float rli[16];
  #pragma unroll
  for(int r=0;r<16;++r)rli[r]=__builtin_amdgcn_rcpf(wsf[32+crow(r,hi)]);
  bf16*Ow=O0+(long)(wid*QBLK)*QP;
  { bf16*stg=(bf16*)(shm+LDS_OST)+wid*2048;
    #pragma unroll
    for(int r=0;r<16;++r){const int orow=crow(r,hi);
      #pragma unroll
      for(int d0=0;d0<2;++d0)stg[orow*64+d0*32+r32]=__float2bfloat16(o[d0][r]*rli[r]);}
    asm volatile("s_waitcnt lgkmcnt(0)":::"memory");
    #pragma unroll
    for(int i=0;i<4;++i){const int row=i*8+(lane>>3),ch=lane&7; const u32x4 v=*(const u32x4*)(stg+row*64+ch*8); ATTN_STORE16(Ow+(long)row*QP+ch*8,v);} }
  asm volatile("s_waitcnt lgkmcnt(0)\n\ts_barrier":::"memory");
  #undef DMA_K
  #undef DMA_V
  #undef CMASK
  #undef START
  #undef RESC
  #undef ROT
}
constexpr int ATTN_LDS_BYTES=LDS_BYTES;
#undef SBAR
#undef WAIT_BAR
}
struct Frame { LAS unsigned char* lds; int tid, lane, wave, gw, ngw, bid, nb; };

__device__ __forceinline__ void tp_load(f32x4 (&v)[8], const float* W, int Nsrc, int scol0, int k0, int lane) {
    const float* p = W + (size_t)(k0 + (lane >> 3)) * Nsrc + scol0 + 4 * (lane & 7);
#pragma unroll
    for (int i = 0; i < 8; ++i) v[i] = *(const f32x4*)(p + (size_t)(8 * i) * Nsrc);
}
__device__ __forceinline__ void tp_store(const f32x4 (&v)[8], int K, bf16_t* WT, int drow0, int k0, LAS float* scr, int lane, const float sc = 1.f, const bool tiled = false) {
    { LAS float* d = scr + (lane >> 3) * 33 + 4 * (lane & 7);
#pragma unroll
      for (int i = 0; i < 8; ++i) { d[(8 * i) * 33 + 0] = v[i].x; d[(8 * i) * 33 + 1] = v[i].y; d[(8 * i) * 33 + 2] = v[i].z; d[(8 * i) * 33 + 3] = v[i].w; } }
    asm volatile("s_waitcnt lgkmcnt(0)" ::: "memory");
    const int c = lane & 7;
#pragma unroll
    for (int j = 0; j < 4; ++j) { const int n = (lane >> 3) + 8 * j; const LAS float* s = scr + (8 * c) * 33 + n;
        u32x4 o; o.x = pk2(s[0 * 33] * sc, s[1 * 33] * sc); o.y = pk2(s[2 * 33] * sc, s[3 * 33] * sc); o.z = pk2(s[4 * 33] * sc, s[5 * 33] * sc); o.w = pk2(s[6 * 33] * sc, s[7 * 33] * sc);
        const int rr = drow0 + n;
        bf16_t* dp = tiled ? WT + (((size_t)(rr >> 8) * (K >> 6) + (k0 >> 6)) * 256 + (rr & 255)) * 64 + 8 * c : WT + (size_t)rr * K + k0 + 8 * c;
        *(u32x4*)dp = o; }
    asm volatile("s_waitcnt lgkmcnt(0)" ::: "memory");
}
__device__ __forceinline__ void conv_plain(const Frame& F, const float* W, int K, int Nsrc, int Nd, bf16_t* WT, LAS float* scr, const bool tiled = false) {
    const int nblk = Nd / 32, nitems = (K / 64) * nblk;
    for (int it = F.gw; it < nitems; it += 2 * F.ngw) { const int it2 = it + F.ngw; const bool two = it2 < nitems;
        const int kb = it / nblk, nb = it % nblk, kb2 = it2 / nblk, nb2 = it2 % nblk;
        f32x4 va[8], vb[8];
        tp_load(va, W, Nsrc, 32 * nb, 64 * kb, F.lane); if (two) tp_load(vb, W, Nsrc, 32 * nb2, 64 * kb2, F.lane);
        tp_store(va, K, WT, 32 * nb, 64 * kb, scr, F.lane, 1.f, tiled); if (two) tp_store(vb, K, WT, 32 * nb2, 64 * kb2, scr, F.lane, 1.f, tiled); }
}
__device__ __forceinline__ int swiglu_scol(int n0) { const int pn = n0 >> 8, bj = (n0 >> 7) & 1, j = n0 & 127; return bj * FFH + 128 * pn + j; }
__device__ __forceinline__ void conv_swiglu(const Frame& F, const float* W, bf16_t* WT, LAS float* scr) {
    const int nblk = FF2 / 32, nitems = (DM / 64) * nblk;
    for (int it = F.gw; it < nitems; it += 2 * F.ngw) { const int it2 = it + F.ngw; const bool two = it2 < nitems;
        const int kb = it / nblk, n0 = 32 * (it % nblk), kb2 = it2 / nblk, n02 = 32 * (it2 % nblk);
        f32x4 va[8], vb[8];
        tp_load(va, W, FF2, swiglu_scol(n0), 64 * kb, F.lane); if (two) tp_load(vb, W, FF2, swiglu_scol(n02), 64 * kb2, F.lane);
        tp_store(va, DM, WT, n0, 64 * kb, scr, F.lane, ((n0 >> 7) & 1) ? -0.6931471805599453f : -LOG2E); if (two) tp_store(vb, DM, WT, n02, 64 * kb2, scr, F.lane, ((n02 >> 7) & 1) ? -0.6931471805599453f : -LOG2E); }
}
__device__ __forceinline__ void conv_l0_in(const Frame& F, const Params& P, int half, unsigned char* ws) {
    LAS float* scr = (LAS float*)(F.lds + F.wave * 16384);
    conv_swiglu(F, as_global(P.ffn_w_in) + (size_t)half * DM * FF2, (bf16_t*)(ws + (half ? WS_WFIN1 : WS_WFIN0)), scr);
}
__device__ __forceinline__ void conv_l0_out(const Frame& F, const Params& P, int half, unsigned char* ws) {
    LAS float* scr = (LAS float*)(F.lds + F.wave * 16384);
    conv_plain(F, as_global(P.ffn_w_out) + (size_t)half * FFH * DM, FFH, DM, DM, (bf16_t*)(ws + (half ? WS_WFOUT1 : WS_WFOUT0)), scr, true);
}
__device__ __forceinline__ void conv_l0_half(const Frame& F, const Params& P, int half, unsigned char* ws) { conv_l0_in(F, P, half, ws); conv_l0_out(F, P, half, ws); }
__device__ __forceinline__ void conv_even_in(const Frame& F, const Params& P, unsigned char* ws) {
    LAS float* scr = (LAS float*)(F.lds + F.wave * 16384);
    conv_plain(F, as_global(P.even_w_in), DM, EVFULL, EVN, (bf16_t*)(ws + WS_WMIN), scr);
}
__device__ __forceinline__ void conv_even_out(const Frame& F, const Params& P, unsigned char* ws) {
    LAS float* scr = (LAS float*)(F.lds + F.wave * 16384);
    conv_plain(F, as_global(P.even_w_out), DM, DM, DM, (bf16_t*)(ws + WS_WMOUT), scr);
}
__device__ __forceinline__ int odd_scol(int n0) { const int c = n0 - 1024; return (c < 0 || c >= 256) ? n0 : 1024 + 64 * ((c >> 5) & 3) + 32 * (c >> 7) + (c & 31); }
__device__ __forceinline__ void conv_l1_a2(const Frame& F, const Params& P, unsigned char* ws) {
    LAS float* scr = (LAS float*)(F.lds + F.wave * 16384);
    const float* W = as_global(P.odd_w_in); bf16_t* WT = (bf16_t*)(ws + WS_WMIN);
    const int nblk = ODN / 32, nitems = (DM / 64) * nblk;
    for (int it = F.gw; it < nitems; it += 2 * F.ngw) { const int it2 = it + F.ngw; const bool two = it2 < nitems;
        const int kb = it / nblk, n0 = 32 * (it % nblk), kb2 = it2 / nblk, n02 = 32 * (it2 % nblk);
        f32x4 va[8], vb[8];
        tp_load(va, W, ODN, odd_scol(n0), 64 * kb, F.lane); if (two) tp_load(vb, W, ODN, odd_scol(n02), 64 * kb2, F.lane);
        tp_store(va, DM, WT, n0, 64 * kb, scr, F.lane); if (two) tp_store(vb, DM, WT, n02, 64 * kb2, scr, F.lane); }
}

__device__ __forceinline__ void mod_wait(f32x2 (&d)[32], const int n) {
    if (n) asm volatile("s_waitcnt vmcnt(32)" : "+v"(d[0]), "+v"(d[1]), "+v"(d[2]), "+v"(d[3]), "+v"(d[4]), "+v"(d[5]), "+v"(d[6]), "+v"(d[7]), "+v"(d[8]), "+v"(d[9]), "+v"(d[10]), "+v"(d[11]), "+v"(d[12]), "+v"(d[13]), "+v"(d[14]), "+v"(d[15]) :: "memory"); else asm volatile("s_waitcnt vmcnt(0)" : "+v"(d[0]), "+v"(d[1]), "+v"(d[2]), "+v"(d[3]), "+v"(d[4]), "+v"(d[5]), "+v"(d[6]), "+v"(d[7]), "+v"(d[8]), "+v"(d[9]), "+v"(d[10]), "+v"(d[11]), "+v"(d[12]), "+v"(d[13]), "+v"(d[14]), "+v"(d[15]) :: "memory");
    asm volatile("" : "+v"(d[16]), "+v"(d[17]), "+v"(d[18]), "+v"(d[19]), "+v"(d[20]), "+v"(d[21]), "+v"(d[22]), "+v"(d[23]), "+v"(d[24]), "+v"(d[25]), "+v"(d[26]), "+v"(d[27]), "+v"(d[28]), "+v"(d[29]), "+v"(d[30]), "+v"(d[31]));
}
template <bool DBL>
__device__ __forceinline__ void phase_mod(const Frame& F, const Params& P, unsigned char* ws, int ulo, int uhi, int vbid, int vnb) {
    LAS float* sc = (LAS float*)F.lds;
    LAS float* red = sc + 5 * 1024;
    for (int i = F.tid; i < 5 * 1024; i += 512) { const int mi = i >> 10, k = i & 1023; const float v = mi == 0 ? as_global(P.c_ctx)[k] : as_global(P.c)[(mi - 1) * 1024 + k]; sc[i] = v / (1.f + __expf(-v)); }
    __syncthreads();
    float* MOD = (float*)(ws + WS_MOD);
    for (int u = ulo + vbid; u < uhi; u += vnb) {
        const int l = u / 72, n0 = (u % 72) * 128;
        const int kb = F.wave * 128;
        const float* W = as_global(P.mod_w) + (size_t)l * 1024 * 9216 + (size_t)kb * 9216 + n0;
        const unsigned voff = 8u * (unsigned)F.lane;
        f32x2 a0 = {0.f, 0.f}, a1 = {0.f, 0.f}, a2 = {0.f, 0.f}, a3 = {0.f, 0.f}, a4 = {0.f, 0.f};
        f32x2 wa[32];
#define MOD_LD(d, k0) _Pragma("unroll") for (int i_ = 0; i_ < 32; ++i_) asm volatile("global_load_dwordx2 %0, %1, %2" : "=v"(d[i_]) : "v"(voff), "s"(W + (size_t)((k0) + i_) * 9216) : "memory")
#define MOD_USE(d, k0) _Pragma("unroll") for (int i_ = 0; i_ < 32; ++i_) { const f32x2 w = d[i_]; const int k = kb + (k0) + i_; \
            a0 += sc[k] * w; a1 += sc[1024 + k] * w; a2 += sc[2048 + k] * w; a3 += sc[3072 + k] * w; a4 += sc[4096 + k] * w; }
        if constexpr (DBL) { f32x2 wb[32];
            MOD_LD(wa, 0); MOD_LD(wb, 32);
            mod_wait(wa, 1); MOD_USE(wa, 0); MOD_LD(wa, 64);
            mod_wait(wb, 1); MOD_USE(wb, 32); MOD_LD(wb, 96);
            mod_wait(wa, 1); MOD_USE(wa, 64);
            mod_wait(wb, 0); MOD_USE(wb, 96);
        } else {
#pragma unroll 1
            for (int k0 = 0; k0 < 128; k0 += 32) { MOD_LD(wa, k0); mod_wait(wa, 0); MOD_USE(wa, k0); }
        }
#undef MOD_LD
#undef MOD_USE
        *(LAS f32x2*)(red + (F.wave * 5 + 0) * 128 + 2 * F.lane) = a0; *(LAS f32x2*)(red + (F.wave * 5 + 1) * 128 + 2 * F.lane) = a1; *(LAS f32x2*)(red + (F.wave * 5 + 2) * 128 + 2 * F.lane) = a2;
        *(LAS f32x2*)(red + (F.wave * 5 + 3) * 128 + 2 * F.lane) = a3; *(LAS f32x2*)(red + (F.wave * 5 + 4) * 128 + 2 * F.lane) = a4;
        __syncthreads();
        for (int o = F.tid; o < 640; o += 512) { const int mi = o >> 7, c = o & 127; float s = 0.f;
#pragma unroll
            for (int w = 0; w < 8; ++w) s += red[(w * 5 + mi) * 128 + c];
            MOD[(size_t)(l * 5 + mi) * 9216 + n0 + c] = s + as_global(P.mod_b)[(size_t)l * 9216 + n0 + c]; }
        __syncthreads();
    }
}

__device__ __forceinline__ void phase_p0(const Frame& F, const Params& P, unsigned char* ws) {
    const bool shed = (F.nb == 256);
    phase_mod<true>(F, P, ws, 0, shed ? 72 : 144, F.bid, F.nb);
    LAS float* scr = (LAS float*)(F.lds + F.wave * 16384);
    conv_l0_in(F, P, 0, ws);
    if (!shed) { conv_l0_out(F, P, 0, ws); conv_l0_half(F, P, 1, ws); conv_even_out(F, P, ws); }
    if (!shed) conv_even_in(F, P, ws);
    const int gt = F.bid * 512 + F.tid, ngt = F.nb * 512;
    float* GW = (float*)(ws + WS_GW);
    for (int i = gt; i < 16 * 1024; i += ngt) { const int j = i >> 10, k = i & 1023; GW[i] = as_global(P.even_w_in)[(size_t)k * EVFULL + EVN + j]; }
    float* RT = (float*)(ws + WS_ROPE);
    for (int i = gt; i < 64 * 16; i += ngt) { const int p = i >> 4, q = i & 15;
        const float inv = __builtin_amdgcn_exp2f(-(float)q * (13.287712379549449f / 16.f)); const float ang = (float)p * inv;
        const double rev = (double)ang * 0.15915494309189533577; const float fr = (float)(rev - floor(rev));
        RT[2 * i] = __builtin_amdgcn_cosf(fr); RT[2 * i + 1] = __builtin_amdgcn_sinf(fr); }
}

constexpr int NG_LD = 1032, NG_GWB = 0, NG_HB = 16 * NG_LD * 2;
constexpr int NT_OFF = NG_HB + 2 * 16 * NG_LD * 2;
static_assert(NT_OFF + 3 * 5 * 1024 * 4 <= 163840 - 64, "norm LDS");
__device__ __forceinline__ void norm_tables(const Frame& F, const float* nw, const float* MODl, int j, const float* fmod, int fgidx, float fs) {
    LAS float* A = (LAS float*)(F.lds + NT_OFF); LAS float* B = A + 5120; LAS float* G = B + 5120;
#pragma unroll 1
    for (int c = F.tid; c < 1024; c += 512) {
        const float w = nw[c];
        float sc[5], sh[5], gt[5];
#pragma unroll
        for (int mi = 0; mi < 5; ++mi) { sc[mi] = MODl[(size_t)(mi * 9 + 3 * j + 1) * 1024 + c]; sh[mi] = MODl[(size_t)(mi * 9 + 3 * j) * 1024 + c];
            gt[mi] = fmod ? fmod[(size_t)(mi * 9 + fgidx) * 1024 + c] : 0.f; }
#pragma unroll
        for (int mi = 0; mi < 5; ++mi) { A[mi * 1024 + c] = w * (sc[mi] + 1.f); B[mi * 1024 + c] = sh[mi]; G[mi * 1024 + c] = gt[mi] * fs; }
    }
    __syncthreads();
}
__device__ __forceinline__ void norm_finish(const Frame& F, f32x4 (&v)[4], int mi, bf16_t* orow, LAS bf16_t* hrow) {
    const LAS f32x4* A = (const LAS f32x4*)(F.lds + NT_OFF) + mi * 256 + F.lane; const LAS f32x4* B = A + 1280;
    float s = 0.f;
#pragma unroll
    for (int j = 0; j < 4; ++j) s += (v[j].x * v[j].x + v[j].y * v[j].y) + (v[j].z * v[j].z + v[j].w * v[j].w);
    const float rstd = 1.0f / sqrtf(wave_sum(s, F.lane) * (1.f / 1024.f) + EPS);
    unsigned long long* o8 = (unsigned long long*)orow + F.lane;
#pragma unroll
    for (int j = 0; j < 4; ++j) { const f32x4 y = v[j] * rstd * A[64 * j] + B[64 * j];
        const unsigned long long o = (unsigned long long)pk2(y.x, y.y) | ((unsigned long long)pk2(y.z, y.w) << 32);
        o8[64 * j] = o; if (hrow) *(LAS unsigned long long*)(hrow + 256 * j + 4 * F.lane) = o; }
}
__device__ __forceinline__ void norm_one(const Frame& F, const float* xrow, int m, int mi, const bf16_t* slab, float* xout, bf16_t* orow, LAS bf16_t* hrow) {
    f32x4 v[4];
#pragma unroll
    for (int j = 0; j < 4; ++j) v[j] = ((const f32x4*)xrow)[F.lane + 64 * j];
    if (slab && m >= 64 * 256) {
        const bf16_t* sl = slab + (size_t)(((m >> 8) - 64) * 4) * 4 * 65536 + (size_t)(m & 255) * 256 + 4 * F.lane;
        u32x2 b[4][4];
#pragma unroll
        for (int j = 0; j < 4; ++j)
#pragma unroll
            for (int q = 0; q < 4; ++q) b[j][q] = *(const u32x2*)(sl + (size_t)(j * 4 + q) * 65536);
        asm volatile("" :: "v"(v[0]), "v"(v[1]), "v"(v[2]), "v"(v[3]), "v"(b[0][0]), "v"(b[0][1]), "v"(b[0][2]), "v"(b[0][3]), "v"(b[1][0]), "v"(b[1][1]), "v"(b[1][2]), "v"(b[1][3]),
                     "v"(b[2][0]), "v"(b[2][1]), "v"(b[2][2]), "v"(b[2][3]), "v"(b[3][0]), "v"(b[3][1]), "v"(b[3][2]), "v"(b[3][3]) : "memory");
        const LAS f32x4* G = (const LAS f32x4*)(F.lds + NT_OFF) + 2560 + mi * 256 + F.lane;
#pragma unroll
        for (int j = 0; j < 4; ++j) {
            const f32x4 a0 = {bflo(b[j][0].x), bfhi(b[j][0].x), bflo(b[j][0].y), bfhi(b[j][0].y)}, a1 = {bflo(b[j][1].x), bfhi(b[j][1].x), bflo(b[j][1].y), bfhi(b[j][1].y)},
                        a2 = {bflo(b[j][2].x), bfhi(b[j][2].x), bflo(b[j][2].y), bfhi(b[j][2].y)}, a3 = {bflo(b[j][3].x), bfhi(b[j][3].x), bflo(b[j][3].y), bfhi(b[j][3].y)};
            v[j] = v[j] + G[64 * j] * ((a0 + a1) + (a2 + a3));
            ((f32x4*)xout)[F.lane + 64 * j] = v[j]; }
    }
    norm_finish(F, v, mi, orow, hrow);
}
struct TailRow { f32x4 v[4]; u32x2 b[4][4]; };
__device__ __forceinline__ void tail_load(const Frame& F, TailRow& T, const float* xrow, int m, const bf16_t* slab) {
    const bf16_t* sl = slab + (size_t)(((m >> 8) - 64) * 4) * 4 * 65536 + (size_t)(m & 255) * 256 + 4 * F.lane;
#pragma unroll
    for (int j = 0; j < 4; ++j) { T.v[j] = ((const f32x4*)xrow)[F.lane + 64 * j];
#pragma unroll
        for (int q = 0; q < 4; ++q) T.b[j][q] = *(const u32x2*)(sl + (size_t)(j * 4 + q) * 65536); }
    asm volatile("" ::: "memory");
}
__device__ __forceinline__ void tail_finish(const Frame& F, TailRow& T, int mi, float* xout, bf16_t* orow, LAS bf16_t* hrow) {
    asm volatile("" :: "v"(T.v[0]), "v"(T.v[1]), "v"(T.v[2]), "v"(T.v[3]), "v"(T.b[0][0]), "v"(T.b[0][1]), "v"(T.b[0][2]), "v"(T.b[0][3]), "v"(T.b[1][0]), "v"(T.b[1][1]), "v"(T.b[1][2]), "v"(T.b[1][3]),
                 "v"(T.b[2][0]), "v"(T.b[2][1]), "v"(T.b[2][2]), "v"(T.b[2][3]), "v"(T.b[3][0]), "v"(T.b[3][1]), "v"(T.b[3][2]), "v"(T.b[3][3]) : "memory");
    const LAS f32x4* G = (const LAS f32x4*)(F.lds + NT_OFF) + 2560 + mi * 256 + F.lane;
#pragma unroll
    for (int j = 0; j < 4; ++j) {
        const f32x4 a0 = {bflo(T.b[j][0].x), bfhi(T.b[j][0].x), bflo(T.b[j][0].y), bfhi(T.b[j][0].y)}, a1 = {bflo(T.b[j][1].x), bfhi(T.b[j][1].x), bflo(T.b[j][1].y), bfhi(T.b[j][1].y)},
                    a2 = {bflo(T.b[j][2].x), bfhi(T.b[j][2].x), bflo(T.b[j][2].y), bfhi(T.b[j][2].y)}, a3 = {bflo(T.b[j][3].x), bfhi(T.b[j][3].x), bflo(T.b[j][3].y), bfhi(T.b[j][3].y)};
        T.v[j] = T.v[j] + G[64 * j] * ((a0 + a1) + (a2 + a3));
        ((f32x4*)xout)[F.lane + 64 * j] = T.v[j]; }
    norm_finish(F, T.v, mi, orow, hrow);
}
template <bool GATES>
__device__ __forceinline__ void phase_norm_t(const Frame& F, const Params& P, unsigned char* ws, const float* xp, const float* xs, const float* xtail, int l, int j, const bf16_t* fslab, const float* fmod, int fgidx, float fs) {
    const float* MODl = (const float*)(ws + WS_MOD) + (size_t)l * 5 * 9216;
    bf16_t* XN = (bf16_t*)(ws + WS_XN);
    LAS bf16_t* GWB = (LAS bf16_t*)(F.lds + NG_GWB); LAS bf16_t* HB = (LAS bf16_t*)(F.lds + NG_HB);
    if constexpr (GATES) { const f32x4* GW = (const f32x4*)(ws + WS_GW);
        for (int i = F.tid; i < 4096; i += 512) { const f32x4 w = GW[i]; *(LAS u32x2*)(GWB + (i >> 8) * NG_LD + 4 * (i & 255)) = (u32x2){pk2(w.x, w.y), pk2(w.z, w.w)}; } }
    float* const outp = as_global(P.out); float* GATESo = (float*)(ws + WS_GATES);
#define NORM_XROW(m) ((m) < NPR ? xp + (size_t)(m) * 1024 : (((m) >= 64 * 256) ? xtail : xs) + (size_t)((m) - NPR) * 1024)
#define NORM_ISQUAD(mb) (((mb) + 3 * F.ngw < MROWS) && !(fslab && (mb) + 3 * F.ngw >= 64 * 256))
#define NORM_LOADQ(v, mb) do { _Pragma("unroll") for (int k = 0; k < 4; ++k) { const int m = (mb) + k * F.ngw; const f32x4* xr = (const f32x4*)NORM_XROW(m) + F.lane; \
            _Pragma("unroll") for (int q = 0; q < 4; ++q) v[k][q] = xr[64 * q]; } } while (0)
#define NORM_WAITQ(v) asm volatile("" :: "v"(v[0][0]), "v"(v[0][1]), "v"(v[0][2]), "v"(v[0][3]), "v"(v[1][0]), "v"(v[1][1]), "v"(v[1][2]), "v"(v[1][3]), \
                         "v"(v[2][0]), "v"(v[2][1]), "v"(v[2][2]), "v"(v[2][3]), "v"(v[3][0]), "v"(v[3][1]), "v"(v[3][2]), "v"(v[3][3]) : "memory")
#define NORM_GATES_MM(gq) do { if constexpr (GATES) { \
            __syncthreads(); \
            const int w0 = (2 * (gq)) & 7; \
            if (F.wave == w0 || F.wave == ((w0 + 1) & 7)) { \
                const int hbuf = (F.wave == w0) ? 0 : 1; \
                const LAS bf16_t* hb = HB + hbuf * 16 * NG_LD; \
                const int fr = F.lane & 15, g = F.lane >> 4; \
                f32x4 acc = {0.f, 0.f, 0.f, 0.f}; \
                _Pragma("unroll 8") for (int s = 0; s < 32; ++s) acc = mfma16(*(const LAS bf16x8*)(hb + fr * NG_LD + 32 * s + 8 * g), *(const LAS bf16x8*)(GWB + fr * NG_LD + 32 * s + 8 * g), acc); \
                _Pragma("unroll") for (int r = 0; r < 4; ++r) { const int slot = 4 * g + r, mm = F.bid * 8 + (slot & 7) + (4 * (gq) + 2 * hbuf + (slot >> 3)) * F.ngw;       \
                    if (mm < MROWS) GATESo[(size_t)mm * 16 + fr] = acc[r]; } \
            } } } while (0)
#define NORM_FINISHQ(v, mb) do { if constexpr (GATES) __syncthreads();               \
            _Pragma("unroll") for (int k = 0; k < 4; ++k) { const int m = (mb) + k * F.ngw; \
                norm_finish(F, v[k], mod_index(m), XN + (size_t)m * 1024, GATES ? HB + (k >> 1) * 16 * NG_LD + ((k & 1) * 8 + F.wave) * NG_LD : (LAS bf16_t*)nullptr); } } while (0)
    const int ngrp = (MROWS + 4 * F.ngw - 1) / (4 * F.ngw);
    const int mb0 = F.gw, mb1 = F.gw + 4 * F.ngw;
    const bool q0 = NORM_ISQUAD(mb0), q1 = q0 && ngrp > 1 && NORM_ISQUAD(mb1);
    f32x4 va[4][4], vb[4][4];
    if (q0) NORM_LOADQ(va, mb0);
    norm_tables(F, as_global(P.norm_w) + (size_t)(l * 3 + j) * 1024, MODl, j, fmod, fgidx, fs);
    int gq0 = 0;
    const int mt0 = F.gw + 8 * F.ngw, mt1 = mt0 + F.ngw;
    const bool tail2 = q0 && q1 && fslab && ngrp == 3 && mt0 >= 64 * 256 && mt1 < MROWS && mt1 + F.ngw >= MROWS;
    if (tail2) {
        NORM_LOADQ(vb, mb1);
        NORM_WAITQ(va); NORM_FINISHQ(va, mb0); NORM_GATES_MM(0);
        TailRow T0, T1;
        tail_load(F, T0, NORM_XROW(mt0), mt0, fslab);
        NORM_WAITQ(vb); NORM_FINISHQ(vb, mb1); NORM_GATES_MM(1);
        tail_load(F, T1, NORM_XROW(mt1), mt1, fslab);
        if constexpr (GATES) __syncthreads();
        tail_finish(F, T0, mod_index(mt0), outp + (size_t)mt0 * 1024, XN + (size_t)mt0 * 1024, GATES ? HB + F.wave * NG_LD : (LAS bf16_t*)nullptr);
        tail_finish(F, T1, mod_index(mt1), outp + (size_t)mt1 * 1024, XN + (size_t)mt1 * 1024, GATES ? HB + (8 + F.wave) * NG_LD : (LAS bf16_t*)nullptr);
        NORM_GATES_MM(2);
        gq0 = ngrp;
    } else if (q0 && q1 && !fslab && ngrp == 3 && mt1 < MROWS && mt1 + F.ngw >= MROWS) {
        NORM_LOADQ(vb, mb1);
        NORM_WAITQ(va); NORM_FINISHQ(va, mb0); NORM_GATES_MM(0);
        f32x4 vt[2][4];
#pragma unroll
        for (int k = 0; k < 2; ++k) { const f32x4* xr = (const f32x4*)NORM_XROW(mt0 + k * F.ngw) + F.lane;
#pragma unroll
            for (int q = 0; q < 4; ++q) vt[k][q] = xr[64 * q]; }
        asm volatile("" ::: "memory");
        NORM_WAITQ(vb); NORM_FINISHQ(vb, mb1); NORM_GATES_MM(1);
        asm volatile("" :: "v"(vt[0][0]), "v"(vt[0][1]), "v"(vt[0][2]), "v"(vt[0][3]), "v"(vt[1][0]), "v"(vt[1][1]), "v"(vt[1][2]), "v"(vt[1][3]) : "memory");
        if constexpr (GATES) __syncthreads();
#pragma unroll
        for (int k = 0; k < 2; ++k) { const int m = mt0 + k * F.ngw; norm_finish(F, vt[k], mod_index(m), XN + (size_t)m * 1024, GATES ? HB + (k * 8 + F.wave) * NG_LD : (LAS bf16_t*)nullptr); }
        NORM_GATES_MM(2);
        gq0 = ngrp;
    } else if (q0) {
        if (q1) NORM_LOADQ(vb, mb1);
        NORM_WAITQ(va); NORM_FINISHQ(va, mb0); NORM_GATES_MM(0);
        gq0 = 1;
        if (q1) { NORM_WAITQ(vb); NORM_FINISHQ(vb, mb1); NORM_GATES_MM(1); gq0 = 2; }
    }
#pragma unroll 1
    for (int gq = gq0; gq < ngrp; ++gq) {
        const int mb = F.gw + 4 * gq * F.ngw;
        if (NORM_ISQUAD(mb)) {
            NORM_LOADQ(va, mb); NORM_WAITQ(va); NORM_FINISHQ(va, mb);
        } else {
            if constexpr (GATES) __syncthreads();
#pragma unroll 1
            for (int k = 0; k < 4; ++k) { const int m = mb + k * F.ngw; if (m >= MROWS) break;
                norm_one(F, NORM_XROW(m), m, mod_index(m), fslab, outp + (size_t)m * 1024, XN + (size_t)m * 1024, GATES ? HB + (k >> 1) * 16 * NG_LD + ((k & 1) * 8 + F.wave) * NG_LD : (LAS bf16_t*)nullptr); }
        }
        NORM_GATES_MM(gq);
    }
#undef NORM_GATES_MM
#undef NORM_FINISHQ
#undef NORM_WAITQ
#undef NORM_LOADQ
#undef NORM_ISQUAD
#undef NORM_XROW
}
__device__ __forceinline__ void phase_norm(const Frame& F, const Params& P, unsigned char* ws, const float* xp, const float* xs, const float* xtail, int l, int j, const bf16_t* fslab, const float* fmod, int fgidx, float fs) {
    phase_norm_t<false>(F, P, ws, xp, xs, xtail, l, j, fslab, fmod, fgidx, fs);
}
__device__ __forceinline__ void phase_norm_gates(const Frame& F, const Params& P, unsigned char* ws, const float* xp, const float* xs, const float* xtail, const bf16_t* fslab, const float* fmod, int fgidx, float fs) {
    phase_norm_t<true>(F, P, ws, xp, xs, xtail, 0, 1, fslab, fmod, fgidx, fs);
}
__device__ __forceinline__ void final_finish(const Frame& F, f32x4 (&v)[4], const f32x4 (&w)[4], f32x4* xr) {
    float s = 0.f;
#pragma unroll
    for (int j = 0; j < 4; ++j) s += (v[j].x * v[j].x + v[j].y * v[j].y) + (v[j].z * v[j].z + v[j].w * v[j].w);
    const float rstd = 1.0f / sqrtf(wave_sum(s, F.lane) * (1.f / 1024.f) + EPS);
#pragma unroll
    for (int j = 0; j < 4; ++j) xr[64 * j] = v[j] * rstd * w[j];
}
__device__ __forceinline__ void phase_final(const Frame& F, const Params& P, const bf16_t* fslab, const float* fmod, int fgidx, float fs) {
    f32x4 w[4];
#pragma unroll
    for (int q = 0; q < 4; ++q) w[q] = ((const f32x4*)as_global(P.final_norm_w))[F.lane + 64 * q];
    float* const outp = as_global(P.out);
    const int npair = fslab ? (64 * 256) : MROWS;
    int mstart = F.gw;
    {
        const int mb0 = F.gw, mb1 = F.gw + 4 * F.ngw, mt0 = F.gw + 8 * F.ngw, mt1 = mt0 + F.ngw;
        if (fslab && mb1 + 3 * F.ngw < npair && mt0 >= npair && mt1 < MROWS && mt1 + F.ngw >= MROWS) {
            f32x4 va[4][4], vb[4][4];
#define FIN_LOADQ(v, mb) do { _Pragma("unroll") for (int k = 0; k < 4; ++k) { const f32x4* xr = (const f32x4*)(outp + (size_t)((mb) + k * F.ngw) * 1024) + F.lane; \
                _Pragma("unroll") for (int j = 0; j < 4; ++j) v[k][j] = xr[64 * j]; } } while (0)
#define FIN_WAITQ(v) asm volatile("" :: "v"(v[0][0]), "v"(v[0][1]), "v"(v[0][2]), "v"(v[0][3]), "v"(v[1][0]), "v"(v[1][1]), "v"(v[1][2]), "v"(v[1][3]), \
                     "v"(v[2][0]), "v"(v[2][1]), "v"(v[2][2]), "v"(v[2][3]), "v"(v[3][0]), "v"(v[3][1]), "v"(v[3][2]), "v"(v[3][3]) : "memory")
#define FIN_FINQ(v, mb) do { _Pragma("unroll") for (int k = 0; k < 4; ++k) final_finish(F, v[k], w, (f32x4*)(outp + (size_t)((mb) + k * F.ngw) * 1024) + F.lane); } while (0)
#define FIN_TAIL(T, gt, m) do { const float* gate = fmod + (size_t)(mod_index(m) * 9 + fgidx) * 1024; \
                asm volatile("" :: "v"(T.v[0]), "v"(T.v[1]), "v"(T.v[2]), "v"(T.v[3]), "v"(T.b[0][0]), "v"(T.b[0][1]), "v"(T.b[0][2]), "v"(T.b[0][3]), "v"(T.b[1][0]), "v"(T.b[1][1]), "v"(T.b[1][2]), "v"(T.b[1][3]), \
                     "v"(T.b[2][0]), "v"(T.b[2][1]), "v"(T.b[2][2]), "v"(T.b[2][3]), "v"(T.b[3][0]), "v"(T.b[3][1]), "v"(T.b[3][2]), "v"(T.b[3][3]) : "memory"); \
                _Pragma("unroll") for (int j = 0; j < 4; ++j) { const f32x4 g4 = ((const f32x4*)gate)[F.lane + 64 * j]; \
                    const f32x4 a0 = {bflo(T.b[j][0].x), bfhi(T.b[j][0].x), bflo(T.b[j][0].y), bfhi(T.b[j][0].y)}, a1 = {bflo(T.b[j][1].x), bfhi(T.b[j][1].x), bflo(T.b[j][1].y), bfhi(T.b[j][1].y)}, \
                                a2 = {bflo(T.b[j][2].x), bfhi(T.b[j][2].x), bflo(T.b[j][2].y), bfhi(T.b[j][2].y)}, a3 = {bflo(T.b[j][3].x), bfhi(T.b[j][3].x), bflo(T.b[j][3].y), bfhi(T.b[j][3].y)}; \
                    T.v[j] = T.v[j] + g4 * fs * ((a0 + a1) + (a2 + a3)); } \
                final_finish(F, T.v, w, (f32x4*)(outp + (size_t)(m) * 1024) + F.lane); } while (0)
            FIN_LOADQ(va, mb0); FIN_LOADQ(vb, mb1);
            FIN_WAITQ(va); FIN_FINQ(va, mb0);
            TailRow T0, T1;
            tail_load(F, T0, outp + (size_t)mt0 * 1024, mt0, fslab);
            FIN_WAITQ(vb); FIN_FINQ(vb, mb1);
            tail_load(F, T1, outp + (size_t)mt1 * 1024, mt1, fslab);
            FIN_TAIL(T0, g0, mt0); FIN_TAIL(T1, g1, mt1);
#undef FIN_TAIL
#undef FIN_FINQ
#undef FIN_WAITQ
#undef FIN_LOADQ
            return;
        }
    }
    for (; mstart + 3 * F.ngw < npair; mstart += 4 * F.ngw) {
        f32x4 v[4][4];
#pragma unroll
        for (int k = 0; k < 4; ++k) { const f32x4* xr = (const f32x4*)(outp + (size_t)(mstart + k * F.ngw) * 1024) + F.lane;
#pragma unroll
            for (int j = 0; j < 4; ++j) v[k][j] = xr[64 * j]; }
        asm volatile("" :: "v"(v[0][0]), "v"(v[0][1]), "v"(v[0][2]), "v"(v[0][3]), "v"(v[1][0]), "v"(v[1][1]), "v"(v[1][2]), "v"(v[1][3]),
                     "v"(v[2][0]), "v"(v[2][1]), "v"(v[2][2]), "v"(v[2][3]), "v"(v[3][0]), "v"(v[3][1]), "v"(v[3][2]), "v"(v[3][3]) : "memory");
#pragma unroll
        for (int k = 0; k < 4; ++k) final_finish(F, v[k], w, (f32x4*)(outp + (size_t)(mstart + k * F.ngw) * 1024) + F.lane);
    }
    for (int m = mstart; m < MROWS; m += F.ngw) {
        f32x4* xr = (f32x4*)(as_global(P.out) + (size_t)m * 1024) + F.lane;
        f32x4 v[4]; float s = 0.f;
#pragma unroll
        for (int j = 0; j < 4; ++j) v[j] = xr[64 * j];
        if (fslab && m >= 64 * 256) { const int mi = mod_index(m); const float* gate = fmod + (size_t)(mi * 9 + fgidx) * 1024;
            const bf16_t* sl = fslab + (size_t)(((m >> 8) - 64) * 4) * 4 * 65536 + (size_t)(m & 255) * 256 + 4 * F.lane;
            u32x2 b[4][4]; f32x4 gt[4];
#pragma unroll
            for (int j = 0; j < 4; ++j) {
#pragma unroll
                for (int q = 0; q < 4; ++q) b[j][q] = *(const u32x2*)(sl + (size_t)(j * 4 + q) * 65536);
                gt[j] = ((const f32x4*)gate)[F.lane + 64 * j]; }
            asm volatile("" :: "v"(b[0][0]), "v"(b[0][1]), "v"(b[0][2]), "v"(b[0][3]), "v"(b[1][0]), "v"(b[1][1]), "v"(b[1][2]), "v"(b[1][3]), "v"(b[2][0]), "v"(b[2][1]), "v"(b[2][2]), "v"(b[2][3]), "v"(b[3][0]), "v"(b[3][1]), "v"(b[3][2]), "v"(b[3][3]), "v"(gt[0]), "v"(gt[1]), "v"(gt[2]), "v"(gt[3]) : "memory");
#pragma unroll
            for (int j = 0; j < 4; ++j) {
                const f32x4 a0 = {bflo(b[j][0].x), bfhi(b[j][0].x), bflo(b[j][0].y), bfhi(b[j][0].y)}, a1 = {bflo(b[j][1].x), bfhi(b[j][1].x), bflo(b[j][1].y), bfhi(b[j][1].y)},
                            a2 = {bflo(b[j][2].x), bfhi(b[j][2].x), bflo(b[j][2].y), bfhi(b[j][2].y)}, a3 = {bflo(b[j][3].x), bfhi(b[j][3].x), bflo(b[j][3].y), bfhi(b[j][3].y)};
                v[j] = v[j] + gt[j] * fs * ((a0 + a1) + (a2 + a3)); } }
#pragma unroll
        for (int j = 0; j < 4; ++j) s += (v[j].x * v[j].x + v[j].y * v[j].y) + (v[j].z * v[j].z + v[j].w * v[j].w);
        const float rstd = 1.0f / sqrtf(wave_sum(s, F.lane) * (1.f / 1024.f) + EPS);
#pragma unroll
        for (int j = 0; j < 4; ++j) xr[64 * j] = v[j] * rstd * ((const f32x4*)as_global(P.final_norm_w))[F.lane + 64 * j];
    }
}
constexpr int EC_RQ = 0, EC_RK = 256, EC_RV = 512, EC_RG = 1024, EC_GQ = 1536, EC_GK = 2048, EC_GV = 2560, EC_GG = 3072;
constexpr int S128 = 136, S64 = 72, SF = 68;
constexpr int PL_KN = 0, PL_QN = PL_KN + 64 * S128 * 2, PL_VV = PL_QN + 64 * S128 * 2;
constexpr int PL_KK = PL_VV + 64 * S128 * 2, PL_QK = PL_KK + 64 * SF * 4;
constexpr int PL_M = PL_KK + 34816;
constexpr int PL_TB = PL_M + 34816;
constexpr int PL_GC = PL_TB + 4 * 64 * S64 * 2;
constexpr int PL_END = PL_GC + 6 * 64 * 4;
static_assert(PL_END <= 163840 - 1024, "prep LDS");


__device__ __forceinline__ float rdlane(float v, int l) { return __builtin_bit_cast(float, __builtin_amdgcn_readlane(__builtin_bit_cast(int, v), l)); }
struct TriGrp { float t0, t1; f32x4 m[8]; };
__device__ __forceinline__ void tri_ld(TriGrp& G, const LAS float* MT, const LAS float* TL, int j, int b, int lane) {
    G.t0 = TL[j * SF + lane]; G.t1 = TL[(j + 1) * SF + lane];
    const LAS f32x4* p0 = (const LAS f32x4*)(MT + j * SF + 16 * b); const LAS f32x4* p1 = (const LAS f32x4*)(MT + (j + 1) * SF + 16 * b);
    G.m[0] = p0[0]; G.m[1] = p0[1]; G.m[2] = p0[2]; G.m[3] = p0[3]; G.m[4] = p1[0]; G.m[5] = p1[1]; G.m[6] = p1[2]; G.m[7] = p1[3];
}
__device__ __forceinline__ void tri_fma(f32x2 (&acc)[8], const TriGrp& G) {
#pragma unroll
    for (int k = 0; k < 4; ++k) { acc[2 * k] += (f32x2){G.m[k].x, G.m[k].y} * G.t0; acc[2 * k + 1] += (f32x2){G.m[k].z, G.m[k].w} * G.t0; }
#pragma unroll
    for (int k = 0; k < 4; ++k) { acc[2 * k] += (f32x2){G.m[4 + k].x, G.m[4 + k].y} * G.t1; acc[2 * k + 1] += (f32x2){G.m[4 + k].z, G.m[4 + k].w} * G.t1; }
}
__device__ __forceinline__ void tri_inverse(const LAS float* MT, LAS float* TL, LAS bf16_t* TBu, LAS bf16_t* TBw, float su, float sw, int cpos, int lane) {
#pragma unroll
    for (int b = 0; b < 4; ++b) {
        asm volatile("" : "+v"(lane));
        f32x2 acc[8];
#pragma unroll
        for (int r = 0; r < 8; ++r) acc[r] = (f32x2){0.f, 0.f};
        if (b > 0) {
            TriGrp GA, GB;
            tri_ld(GA, MT, TL, 0, b, lane);
#pragma unroll 1
            for (int j = 0; j < 16 * b; j += 4) {
                tri_ld(GB, MT, TL, j + 2, b, lane);
                tri_fma(acc, GA);
                tri_ld(GA, MT, TL, (j + 4 < 16 * b) ? j + 4 : 0, b, lane);
                tri_fma(acc, GB);
            }
        }
        f32x4 mq[4];
        { const LAS f32x4* dp = (const LAS f32x4*)(MT + (16 * b + (lane & 15)) * SF + 16 * b); mq[0] = dp[0]; mq[1] = dp[1]; mq[2] = dp[2]; mq[3] = dp[3]; }
        float T[16];
#pragma unroll
        for (int r = 0; r < 16; ++r) T[r] = ((lane == 16 * b + r) ? 1.f : 0.f) - acc[r >> 1][r & 1];
#pragma unroll
        for (int q = 0; q < 15; ++q) {
#pragma unroll
            for (int r = q + 1; r < 16; ++r) T[r] -= rdlane(mq[r >> 2][r & 3], q) * T[q];
        }
#pragma unroll
        for (int r = 0; r < 16; ++r) { TL[(16 * b + r) * SF + lane] = T[r]; const f32x2 t2 = (f32x2){su, sw} * T[r]; const unsigned w2 = pk2(t2.x, t2.y);
            TBu[(16 * b + r) * S64 + cpos] = (bf16_t)(w2 & 0xffffu); TBw[(16 * b + r) * S64 + cpos] = (bf16_t)(w2 >> 16); }
    }
}

constexpr int PA_NR = 11;
struct PrepRows { unsigned q[PA_NR], k[PA_NR], v[PA_NR]; };
__device__ __forceinline__ void prep_rows_compute(PrepRows& R, const Params& P, unsigned char* ws, int chunk, int h, int wave, int lane) {
    const bf16_t* E = (const bf16_t*)(ws + WS_BIG);
    const int row0 = chunk * 64, cps = chunk < 64 ? 4 : 64, cis = chunk < 64 ? (chunk & 3) : ((chunk - 64) & 63);
    const int p0 = PA_NR * (wave - 2), nr = (wave == 7) ? 64 - PA_NR * 5 : PA_NR;
    float cw[3][3][2];
#pragma unroll
    for (int t = 0; t < 3; ++t)
#pragma unroll
        for (int j = 0; j < 3; ++j) { const f32x2 w = *(const f32x2*)(as_global(P.gdn_conv_w) + (size_t)j * 1536 + t * 512 + h * 128 + 2 * lane); cw[t][j][0] = w.x; cw[t][j][1] = w.y; }
    unsigned wr[3][PA_NR + 2];
#pragma unroll
    for (int i = 0; i < PA_NR + 2; ++i) { const int pp = p0 - 1 + i; const bool ok = (pp >= 0 || cis > 0) && (pp < 64 || (pp == 64 && cis < cps - 1));
        const bf16_t* src = E + (size_t)(row0 + (ok ? pp : p0)) * EVN + EC_GQ + h * 128 + 2 * lane;
#pragma unroll
        for (int t = 0; t < 3; ++t) asm volatile("global_load_dword %0, %1, off offset:%c2" : "=v"(wr[t][i]) : "v"(src), "i"(t * 1024) : "memory"); }
    asm volatile("s_waitcnt vmcnt(0)" : "+v"(wr[0][0]), "+v"(wr[0][1]), "+v"(wr[0][2]), "+v"(wr[0][3]), "+v"(wr[0][4]), "+v"(wr[0][5]), "+v"(wr[0][6]), "+v"(wr[0][7]), "+v"(wr[0][8]), "+v"(wr[0][9]), "+v"(wr[0][10]), "+v"(wr[0][11]), "+v"(wr[0][12]) :: "memory");
    asm volatile("" : "+v"(wr[1][0]), "+v"(wr[1][1]), "+v"(wr[1][2]), "+v"(wr[1][3]), "+v"(wr[1][4]), "+v"(wr[1][5]), "+v"(wr[1][6]), "+v"(wr[1][7]), "+v"(wr[1][8]), "+v"(wr[1][9]), "+v"(wr[1][10]), "+v"(wr[1][11]), "+v"(wr[1][12]));
    asm volatile("" : "+v"(wr[2][0]), "+v"(wr[2][1]), "+v"(wr[2][2]), "+v"(wr[2][3]), "+v"(wr[2][4]), "+v"(wr[2][5]), "+v"(wr[2][6]), "+v"(wr[2][7]), "+v"(wr[2][8]), "+v"(wr[2][9]), "+v"(wr[2][10]), "+v"(wr[2][11]), "+v"(wr[2][12]));
#pragma unroll
    for (int i = 0; i < PA_NR + 2; ++i) { const int pp = p0 - 1 + i;
        if ((pp < 0 && cis == 0) || (pp > 63 && cis == cps - 1)) {
#pragma unroll
            for (int t = 0; t < 3; ++t) wr[t][i] = 0u; } }
#pragma unroll
    for (int rr = 0; rr < PA_NR; ++rr) {
        if (rr < nr) {
            float y[3][2];
#pragma unroll
            for (int t = 0; t < 3; ++t) { const unsigned w0 = wr[t][rr], w1 = wr[t][rr + 1], w2 = wr[t][rr + 2];
                y[t][0] = silu_f(cw[t][0][0] * bflo(w0) + cw[t][1][0] * bflo(w1) + cw[t][2][0] * bflo(w2));
                y[t][1] = silu_f(cw[t][0][1] * bfhi(w0) + cw[t][1][1] * bfhi(w1) + cw[t][2][1] * bfhi(w2)); }
            const float sq = wave_sum(y[0][0] * y[0][0] + y[0][1] * y[0][1], lane), sk = wave_sum(y[1][0] * y[1][0] + y[1][1] * y[1][1], lane);
            const float rq = (1.0f / sqrtf(sq + EPS)) * 0.08838834764831845f, rk = 1.0f / sqrtf(sk + EPS);
            R.q[rr] = pk2(y[0][0] * rq, y[0][1] * rq); R.k[rr] = pk2(y[1][0] * rk, y[1][1] * rk); R.v[rr] = pk2(y[2][0], y[2][1]);
        } else { R.q[rr] = 0u; R.k[rr] = 0u; R.v[rr] = 0u; }
    }
}
__device__ __forceinline__ void prep_rows_commit(const PrepRows& R, LAS unsigned char* L, unsigned char* ws, int chunk, int h, int wave, int lane) {
    LAS bf16_t* KN = (LAS bf16_t*)(L + PL_KN); LAS bf16_t* QN = (LAS bf16_t*)(L + PL_QN); LAS bf16_t* VV = (LAS bf16_t*)(L + PL_VV);
    bf16_t* qn_g = (bf16_t*)(ws + WS_QN);
    const int p0 = PA_NR * (wave - 2), nr = (wave == 7) ? 64 - PA_NR * 5 : PA_NR;
#pragma unroll
    for (int rr = 0; rr < PA_NR; ++rr) { if (rr < nr) { const int p = p0 + rr;
        *(LAS unsigned*)(QN + p * S128 + 2 * lane) = R.q[rr]; *(LAS unsigned*)(KN + p * S128 + 2 * lane) = R.k[rr]; *(LAS unsigned*)(VV + p * S128 + 2 * lane) = R.v[rr];
        *(unsigned*)(qn_g + (size_t)(chunk * 64 + p) * 512 + h * 128 + 2 * lane) = R.q[rr]; } }
}
struct PrepGates { float a, b, dt, al; };
__device__ __forceinline__ void prep_gates_load(PrepGates& G, const Params& P, unsigned char* ws, int chunk, int h, int wave, int lane) {
    const int pos = wave ? 63 - lane : lane; const float* gt = (const float*)(ws + WS_GATES) + (size_t)(chunk * 64 + pos) * 16;
    G.a = gt[wave * 4 + h]; G.b = gt[8 + wave * 4 + h]; G.dt = as_global(P.gdn_dt_bias)[wave * 4 + h]; G.al = as_global(P.gdn_A_log)[wave * 4 + h];
}
__device__ __forceinline__ void prep_gates_commit(const PrepGates& G, LAS unsigned char* L, unsigned char* ws, int chunk, int h, int wave, int lane) {
    LAS float* GCS = (LAS float*)(L + PL_GC); LAS float* BET = GCS + 128; LAS float* EGC = GCS + 256;
    const int dir = wave, pr = lane;
    const float xg = G.a + G.dt;
    const float sp = fmaxf(xg, 0.f) + __logf(1.f + __expf(-fabsf(xg)));
    float gc = -__expf(G.al) * sp;
#pragma unroll
    for (int o = 1; o < 64; o <<= 1) { const float t = __builtin_bit_cast(float, __builtin_amdgcn_ds_bpermute((lane - o) << 2, __builtin_bit_cast(int, gc))); if (lane >= o) gc += t; }
    GCS[dir * 64 + pr] = gc; BET[dir * 64 + pr] = sigmoid_f(G.b); EGC[dir * 64 + pr] = __expf(gc);
    ((float*)(ws + WS_GC))[((size_t)(dir * NCHUNK + chunk) * 4 + h) * 64 + pr] = gc;
}
__device__ __forceinline__ void phase_gdn_prep(const Frame& F, const Params& P, unsigned char* ws, int skip) {
    (void)skip;
    LAS unsigned char* L = F.lds;
    LAS bf16_t* KN = (LAS bf16_t*)(L + PL_KN); LAS bf16_t* QN = (LAS bf16_t*)(L + PL_QN); LAS bf16_t* VV = (LAS bf16_t*)(L + PL_VV);
    LAS float* KK = (LAS float*)(L + PL_KK);
    LAS float* MM = (LAS float*)(L + PL_M); LAS bf16_t* TB = (LAS bf16_t*)(L + PL_TB);
    LAS float* GCS = (LAS float*)(L + PL_GC); LAS float* BET = GCS + 128; LAS float* EGC = GCS + 256;
    const int wave = F.wave;
    int u = F.bid;
    if (u >= NCHUNK * 4) return;
    {
        const int lane = fresh_lane();
        if (wave >= 2) { PrepRows R; prep_rows_compute(R, P, ws, u >> 2, u & 3, wave, lane); prep_rows_commit(R, L, ws, u >> 2, u & 3, wave, lane); }
        else { PrepGates G; prep_gates_load(G, P, ws, u >> 2, u & 3, wave, lane); prep_gates_commit(G, L, ws, u >> 2, u & 3, wave, lane); }
    }
#pragma unroll 1
    for (; u < NCHUNK * 4; u += F.nb) {
        const int chunk = u >> 2, h = u & 3, un = u + F.nb; const bool has_next = un < NCHUNK * 4;
        const int lane = fresh_lane(), tid = wave * 64 + lane, fr = lane & 15, g = lane >> 4;
        __syncthreads();
        {
            const int dk = tid >> 2, pb = tid & 3; unsigned w[8];
#pragma unroll
            for (int i = 0; i < 8; ++i) w[i] = (unsigned)KN[(16 * pb + 2 * i) * S128 + dk] | ((unsigned)KN[(16 * pb + 2 * i + 1) * S128 + dk] << 16);
            u32x4* dst = (u32x4*)((bf16_t*)(ws + WS_KNT) + ((size_t)(chunk * 4 + h) * 128 + dk) * 64 + 16 * pb);
            dst[0] = (u32x4){w[0], w[1], w[2], w[3]}; dst[1] = (u32x4){w[4], w[5], w[6], w[7]};
        }
        {
            bf16_t* ATT = (bf16_t*)(ws + WS_ATT);
#pragma unroll
            for (int e = 0; e < 2; ++e) {
                const int tt = 2 * wave + e, mt = tt >> 2, nt = tt & 3;
                f32x4 ak = {0.f, 0.f, 0.f, 0.f}, aq = {0.f, 0.f, 0.f, 0.f};
#pragma unroll
                for (int s = 0; s < 4; ++s) {
                    const bf16x8 a1 = *(const LAS bf16x8*)(KN + (16 * nt + fr) * S128 + 32 * s + 8 * g);
                    const bf16x8 bk = *(const LAS bf16x8*)(KN + (16 * mt + fr) * S128 + 32 * s + 8 * g);
                    const bf16x8 bq = *(const LAS bf16x8*)(QN + (16 * mt + fr) * S128 + 32 * s + 8 * g);
                    ak = mfma16(a1, bk, ak); aq = mfma16(a1, bq, aq);
                }
                const int pi = 16 * mt + fr, pj0 = 16 * nt + 4 * g;
#pragma unroll
                for (int dir = 0; dir < 2; ++dir) {
                    const int i = dir ? 63 - pi : pi, jb = dir ? 60 - pj0 : pj0;
                    bf16_t* ap = ATT + ((size_t)(dir * NCHUNK + chunk) * 4 + h) * 4096 + i * 64 + jb;
                    if (dir ? (nt < mt) : (nt > mt)) { *(u32x2*)ap = (u32x2){0u, 0u}; continue; }
                    const float gi = GCS[dir * 64 + i], be = BET[dir * 64 + i];
                    const f32x4 gj = *(const LAS f32x4*)(GCS + dir * 64 + jb);
                    float at[4];
#pragma unroll
                    for (int r = 0; r < 4; ++r) { const int q = dir ? 3 - r : r, j = jb + q;
                        const float dec = (j <= i) ? __expf(gi - gj[q]) : 0.f;
                        at[q] = aq[r] * dec;
                        if (j < i) MM[dir * 64 * SF + j * SF + i] = be * ak[r] * dec; }
                    *(u32x2*)ap = (u32x2){pk2(at[0], at[1]), pk2(at[2], at[3])};
                }
            }
        }
        __syncthreads();
        PrepRows R; PrepGates G;
        if (wave < 2) {
            if (has_next) prep_gates_load(G, P, ws, un >> 2, un & 3, wave, lane);
            const float be = BET[wave * 64 + lane];
            tri_inverse(MM + wave * 64 * SF, KK + wave * 64 * SF, TB + (wave * 2 + 0) * 64 * S64, TB + (wave * 2 + 1) * 64 * S64, be, be * EGC[wave * 64 + lane], wave ? 63 - lane : lane, lane);
        } else if (has_next) prep_rows_compute(R, P, ws, un >> 2, un & 3, wave, lane);
        __syncthreads();
        {
            const int dir = wave >> 2, var = (wave >> 1) & 1;
            const LAS bf16_t* SRC = var ? KN : VV; const LAS bf16_t* TT = TB + (dir * 2 + var) * 64 * S64;
            bf16_t* OG = (bf16_t*)(ws + (var ? WS_W : WS_U)) + ((size_t)(dir * NCHUNK + chunk) * 4 + h) * 8192;
            bf16x8 bfr[4][2];
#pragma unroll
            for (int it = 0; it < 4; ++it)
#pragma unroll
                for (int s2 = 0; s2 < 2; ++s2) bfr[it][s2] = *(const LAS bf16x8*)(TT + (16 * it + fr) * S64 + 32 * s2 + 8 * g);
            const int tq = (lane & 15) >> 2, tp = lane & 3;
#pragma unroll
            for (int e = 0; e < 4; ++e) { const int ct = 4 * (wave & 1) + e;
                bf16x8 afr[2];
#pragma unroll
                for (int s2 = 0; s2 < 2; ++s2) { const LAS bf16_t* ap = SRC + (32 * s2 + 8 * g + tq) * S128 + 16 * ct + 4 * tp;
                    const s16x4 lo = __builtin_bit_cast(s16x4, __builtin_amdgcn_ds_read_tr16_b64_v4i16((LAS s16x4*)ap)), hi = __builtin_bit_cast(s16x4, __builtin_amdgcn_ds_read_tr16_b64_v4i16((LAS s16x4*)(ap + 4 * S128)));
                    afr[s2] = (bf16x8){lo[0], lo[1], lo[2], lo[3], hi[0], hi[1], hi[2], hi[3]}; }
#pragma unroll
                for (int it = 0; it < 4; ++it) { f32x4 acc = {0.f, 0.f, 0.f, 0.f};
#pragma unroll
                    for (int s2 = 0; s2 < 2; ++s2) acc = mfma16(afr[s2], bfr[it][s2], acc);
                    const int i = 16 * it + fr, c = 16 * ct + 4 * g;
                    *(u32x2*)(OG + i * 128 + c) = (u32x2){pk2(acc[0], acc[1]), pk2(acc[2], acc[3])}; }
            }
        }
        __syncthreads();
        if (has_next) { if (wave >= 2) prep_rows_commit(R, L, ws, un >> 2, un & 3, wave, lane); else prep_gates_commit(G, L, ws, un >> 2, un & 3, wave, lane); }
    }
    __syncthreads();
}
#ifndef SCAN_PROBE
#define SCAN_PROBE 0
#endif
constexpr int SL_QD = 0, SL_WW = 17408, SL_UU = 34816, SL_KDT = 52224, SL_AT = 70656;
constexpr int SL_OO = 79872, SL_EG = 79872 + 17408;
constexpr int SL_GCP = 98304;
constexpr int SL_QNAT = 9216, SL_KNAT = 18432;

__device__ __forceinline__ int kperm(int c) { return (c & ~31) | ((c & 12) << 1) | ((c & 16) >> 2) | (c & 3); }
__device__ __forceinline__ bf16x8 afrag(const LAS bf16_t* T, int stride, int rowbase, int s, int fr, int g) {
    return *(const LAS bf16x8*)(T + (rowbase + fr) * stride + 32 * s + 8 * g);
}
__device__ __forceinline__ void st_perm8(LAS bf16_t* row, int k0, u32x4 v) {
    *(LAS u32x2*)(row + kperm(k0)) = (u32x2){v.x, v.y}; *(LAS u32x2*)(row + kperm(k0 + 4)) = (u32x2){v.z, v.w};
}
__device__ __forceinline__ u32x4 scale8(u32x4 v, float s) {
    u32x4 o; o.x = pk2(bflo(v.x) * s, bfhi(v.x) * s); o.y = pk2(bflo(v.y) * s, bfhi(v.y) * s); o.z = pk2(bflo(v.z) * s, bfhi(v.z) * s); o.w = pk2(bflo(v.w) * s, bfhi(v.w) * s); return o;
}

struct ScanPF { u32x4 q[2], w[2], u[2], k[2], a; };
__device__ __forceinline__ void gl16(u32x4& d, const void* p) { asm volatile("global_load_dwordx4 %0, %1, off" : "=v"(d) : "v"(p) : "memory"); }
__device__ __forceinline__ void gl4(float& d, const void* p) { asm volatile("global_load_dword %0, %1, off" : "=v"(d) : "v"(p) : "memory"); }
__device__ __forceinline__ void glds4(const void* gsrc, unsigned lds_dst) { unsigned keep;
    asm volatile("s_mov_b32 %0, m0\n\ts_mov_b32 m0, %2\n\ts_nop 0\n\tglobal_load_lds_dword %1, off\n\ts_mov_b32 m0, %0" : "=&s"(keep) : "v"(gsrc), "s"(lds_dst) : "memory"); }
__device__ __forceinline__ void gl16s(u32x4& d, const void* sbase, unsigned voff) { asm volatile("global_load_dwordx4 %0, %1, %2" : "=v"(d) : "v"(voff), "s"(sbase) : "memory"); }
__device__ __forceinline__ void glds4s(const void* sbase, unsigned voff, unsigned lds_dst) { unsigned keep;
    asm volatile("s_mov_b32 %0, m0\n\ts_mov_b32 m0, %3\n\ts_nop 0\n\tglobal_load_lds_dword %1, %2\n\ts_mov_b32 m0, %0" : "=&s"(keep) : "v"(voff), "s"(sbase), "s"(lds_dst) : "memory"); }
struct ScanOff { unsigned q[2], wu[2], k[2], a, gc; };
template <bool GDN>
__device__ __forceinline__ void scan_offsets(ScanOff& o, int tid, int dir, int h) {
    if constexpr (GDN) {
#pragma unroll
        for (int k = 0; k < 2; ++k) { const int it = tid + 512 * k, pr = it >> 4, cc = it & 15, pos = dir ? 63 - pr : pr;
            o.q[k] = (unsigned)(pos * 512 + h * 128 + 8 * cc) * 2u; o.wu[k] = (unsigned)(pr * 128 + 8 * cc) * 2u; }
#pragma unroll
        for (int k = 0; k < 2; ++k) { const int it = tid + 512 * k, dk = it >> 3, c8 = it & 7; o.k[k] = (unsigned)(dk * 64 + 8 * c8) * 2u; }
        { const int pr = tid >> 3, c8 = tid & 7; o.a = (unsigned)(pr * 64 + 8 * c8) * 2u; }
        o.gc = (unsigned)(tid & 63) * 4u;
    } else {
        { const int pr = tid >> 3, cc = tid & 7, pos = dir ? 63 - pr : pr; o.q[0] = (unsigned)(pos * EVN + h * 64 + 8 * cc) * 2u; }
#pragma unroll
        for (int k = 0; k < 2; ++k) { const int it = tid + 512 * k, pr = it >> 4, cc = it & 15, pos = dir ? 63 - pr : pr; o.wu[k] = (unsigned)(pos * EVN + EC_RV + h * 128 + 8 * cc) * 2u; }
        o.q[1] = o.k[0] = o.k[1] = o.a = o.gc = 0u;
    }
}
template <bool GDN, bool FULL>
__device__ __forceinline__ void scan_load(ScanPF& p, unsigned char* ws, const bf16_t* E, const ScanOff& o, int dir, int h, int chunk, unsigned gcslot) {
    const int row0 = chunk * 64;
    if constexpr (GDN) {
        const float* GCg = (const float*)(ws + WS_GC) + ((size_t)(dir * NCHUNK + chunk) * 4 + h) * 64;
        const bf16_t* qn = (const bf16_t*)(ws + WS_QN) + (size_t)row0 * 512; const bf16_t* knT = (const bf16_t*)(ws + WS_KNT) + (size_t)(chunk * 4 + h) * 128 * 64;
        const bf16_t* UG = (const bf16_t*)(ws + WS_U) + ((size_t)(dir * NCHUNK + chunk) * 4 + h) * 8192;
        const bf16_t* WG = (const bf16_t*)(ws + WS_W) + ((size_t)(dir * NCHUNK + chunk) * 4 + h) * 8192;
        const bf16_t* AG = (const bf16_t*)(ws + WS_ATT) + ((size_t)(dir * NCHUNK + chunk) * 4 + h) * 4096;
        glds4s(GCg, o.gc, gcslot);
#pragma unroll
        for (int k = 0; k < 2; ++k) {
            if constexpr (FULL) gl16s(p.q[k], qn, o.q[k]);
            gl16s(p.w[k], WG, o.wu[k]); gl16s(p.u[k], UG, o.wu[k]); }
#pragma unroll
        for (int k = 0; k < 2; ++k) gl16s(p.k[k], knT, o.k[k]);
        if constexpr (FULL) gl16s(p.a, AG, o.a);
    } else {
        const bf16_t* er = E + (size_t)row0 * EVN;
        if constexpr (FULL) gl16s(p.q[0], er + EC_RQ, o.q[0]);
        gl16s(p.k[0], er + EC_RK, o.q[0]);
#pragma unroll
        for (int k = 0; k < 2; ++k) gl16s(p.u[k], er, o.wu[k]);
    }
}
template <bool GDN, bool FULL, int N>
__device__ __forceinline__ void scan_wait(ScanPF& p) {
    if constexpr (GDN && FULL) asm volatile("s_waitcnt vmcnt(%c9)" : "+v"(p.q[0]), "+v"(p.q[1]), "+v"(p.w[0]), "+v"(p.w[1]), "+v"(p.u[0]), "+v"(p.u[1]), "+v"(p.k[0]), "+v"(p.k[1]), "+v"(p.a) : "i"(N) : "memory");
    else if constexpr (GDN) asm volatile("s_waitcnt vmcnt(%c6)" : "+v"(p.w[0]), "+v"(p.w[1]), "+v"(p.u[0]), "+v"(p.u[1]), "+v"(p.k[0]), "+v"(p.k[1]) : "i"(N) : "memory");
    else if constexpr (FULL) asm volatile("s_waitcnt vmcnt(%c4)" : "+v"(p.q[0]), "+v"(p.k[0]), "+v"(p.u[0]), "+v"(p.u[1]) : "i"(N) : "memory");
    else asm volatile("s_waitcnt vmcnt(%c3)" : "+v"(p.k[0]), "+v"(p.u[0]), "+v"(p.u[1]) : "i"(N) : "memory");
}
__device__ __forceinline__ u32x4 rev8(u32x4 v) {
    return (u32x4){(v.w >> 16) | (v.w << 16), (v.z >> 16) | (v.z << 16), (v.y >> 16) | (v.y << 16), (v.x >> 16) | (v.x << 16)};
}
constexpr int SGL = 16, SNG = 64 / SGL;
constexpr size_t WS_SGB = 327 * MiB;
constexpr size_t WS_DLT = 343 * MiB;
constexpr size_t WS_CG = 351 * MiB;
constexpr size_t WS_HEND = 351 * MiB + 4096;

template <bool GDN, int MODE>
__device__ __forceinline__ void scan_unit(const Frame& F, const Params& P, unsigned char* ws, int seq, int h, int dir, int gi, bool dummy) {
    constexpr int DK = GDN ? 128 : 64, NDT = DK / 16, NKS = DK / 32, SQ = GDN ? S128 : S64;
    constexpr bool FULL = (MODE != 1), latent = (MODE != 0), TRK = (GDN && MODE == 1);
    LAS unsigned char* L = F.lds;
    LAS bf16_t* QD = (LAS bf16_t*)(L + SL_QD); LAS bf16_t* WW = (LAS bf16_t*)(L + SL_WW); LAS bf16_t* UU = (LAS bf16_t*)(L + SL_UU);
    LAS bf16_t* KDT = (LAS bf16_t*)(L + SL_KDT); LAS bf16_t* AT = (LAS bf16_t*)(L + SL_AT);
    LAS bf16_t* OO = (LAS bf16_t*)(L + SL_OO); LAS float* EGS = (LAS float*)(L + SL_EG); LAS float* DKS = EGS + 64;
    LAS bf16_t* KNAT = (LAS bf16_t*)(L + SL_KNAT);
    const int wave = F.wave;
    int lane = fresh_lane(), tid = wave * 64 + lane, fr = lane & 15, g = lane >> 4, col = 16 * wave + fr;
    const int cb = latent ? 64 + 64 * seq : 4 * seq, nch = latent ? 64 : 4, n0 = latent ? SGL * gi : 0, ns = latent ? SGL : 4;
    const int ci = (seq * 4 + h) * 2 + dir;
    bf16_t* E = (bf16_t*)(ws + WS_BIG);
    float* sgb = GDN ? (float*)(ws + WS_SGB) + ((size_t)ci * SNG + gi) * 16384 : as_global(P.out) + OUT_CK + ((size_t)ci * SNG + gi) * 8192;
    f32x4 S[NDT], D[TRK ? NDT : 1];
    if constexpr (MODE == 3) {
        { const float* s0 = (GDN ? as_global(P.state_gdn) : as_global(P.state_ret)) + (size_t)((seq * 2 + dir) * 4 + h) * DK * 128;
#pragma unroll
          for (int dt = 0; dt < NDT; ++dt)
#pragma unroll
              for (int r = 0; r < 4; ++r) S[dt][r] = s0[(16 * dt + 4 * g + r) * 128 + col]; }
        if constexpr (GDN) {
            LAS bf16_t* DT0 = (LAS bf16_t*)L;
            if (gi > 0) {
                __syncthreads();
#pragma unroll 1
                for (int gq = 0; gq < gi; ++gq) { const bf16_t* dl = (const bf16_t*)(ws + WS_DLT) + ((size_t)ci * SNG + gq) * 16384;
#pragma unroll
                    for (int k = 0; k < 4; ++k) { const int it = tid + 512 * k, rr = it >> 4, cc = it & 15; *(LAS u32x4*)(DT0 + gq * (128 * S128) + rr * S128 + 8 * cc) = *(const u32x4*)(dl + rr * 128 + 8 * cc); } }
                f32x4 B[NDT], Bn[NDT];
                { const float* bg = sgb - (ptrdiff_t)gi * 16384;
#pragma unroll
                  for (int dt = 0; dt < NDT; ++dt)
#pragma unroll
                      for (int r = 0; r < 4; ++r) B[dt][r] = bg[(16 * dt + 4 * g + r) * 128 + col]; }
                __syncthreads();
#pragma unroll 1
                for (int gq = 0; gq < gi; ++gq) {
                    const float c = ((const float*)(ws + WS_CG))[ci * SNG + gq];
                    { const float* bg = sgb + ((ptrdiff_t)(gq + 1 < gi ? gq + 1 : gq) - gi) * 16384;
#pragma unroll
                      for (int dt = 0; dt < NDT; ++dt)
#pragma unroll
                          for (int r = 0; r < 4; ++r) Bn[dt][r] = bg[(16 * dt + 4 * g + r) * 128 + col]; }
                    const LAS bf16_t* DT = DT0 + gq * (128 * S128);
                    bf16x8 Sb[NKS];
#pragma unroll
                    for (int s2 = 0; s2 < NKS; ++s2) Sb[s2] = pack8(S[2 * s2], S[2 * s2 + 1]);
#pragma unroll
                    for (int dt = 0; dt < NDT; ++dt) { f32x4 t = S[dt] * c + B[dt];
#pragma unroll
                        for (int s2 = 0; s2 < NKS; ++s2) t = mfma16(afrag(DT, S128, 16 * dt, s2, fr, g), Sb[s2], t);
                        S[dt] = t; }
#pragma unroll
                    for (int dt = 0; dt < NDT; ++dt) B[dt] = Bn[dt];
                }
            }
        } else {
            const float x = as_global(P.ret_decay_logit)[dir * 4 + h]; const float cret = __expf((float)(64 * SGL) * -(fmaxf(-x, 0.f) + __logf(1.f + __expf(-fabsf(x)))));
            f32x4 B[SNG - 1][NDT];
#pragma unroll
            for (int gq = 0; gq < SNG - 1; ++gq) { const float* bg = sgb + ((ptrdiff_t)(gq < gi ? gq : 0) - gi) * 8192;
#pragma unroll
                for (int dt = 0; dt < NDT; ++dt)
#pragma unroll
                    for (int r = 0; r < 4; ++r) B[gq][dt][r] = (gq < gi) ? bg[(16 * dt + 4 * g + r) * 128 + col] : 0.f; }
#pragma unroll
            for (int gq = 0; gq < SNG - 1; ++gq) { if (gq < gi) {
#pragma unroll
                for (int dt = 0; dt < NDT; ++dt) S[dt] = S[dt] * cret + B[gq][dt]; } }
        }
        __syncthreads();
    } else {
#pragma unroll
        for (int dt = 0; dt < NDT; ++dt) S[dt] = (f32x4){0.f, 0.f, 0.f, 0.f};
    }
    if constexpr (TRK) {
#pragma unroll
        for (int dt = 0; dt < NDT; ++dt) D[dt] = (f32x4){0.f, 0.f, 0.f, 0.f};
    }
    float crun = 1.f;
    float lg = 0.f;
    if (!GDN) { const float x = as_global(P.ret_decay_logit)[dir * 4 + h]; lg = -(fmaxf(-x, 0.f) + __logf(1.f + __expf(-fabsf(x)))); }
#define CHUNK_OF(nn) (dir ? cb + nch - 1 - (n0 + (nn)) : cb + n0 + (nn))
#define SCAN_STORE_O(cprev) do { const int chunkp_ = (cprev); \
        _Pragma("unroll") for (int k = 0; k < 2; ++k) { const int it = tid + 512 * k, pr = it >> 4, cc = it & 15; \
            const u32x4 v = *(const LAS u32x4*)(OO + pr * S128 + 8 * cc); \
            if (dummy) *(u32x4*)((bf16_t*)(ws + WS_HEND + MiB) + ((((size_t)chunkp_ * 4 + h) * 8192 + pr * 128 + 8 * cc) & 0x3fff8)) = v; \
            else if constexpr (GDN) *(u32x4*)((bf16_t*)(ws + WS_U) + ((size_t)(dir * NCHUNK + chunkp_) * 4 + h) * 8192 + pr * 128 + 8 * cc) = v; \
            else { const int pos = dir ? 63 - pr : pr; *(u32x4*)(E + (size_t)(chunkp_ * 64 + pos) * EVN + (dir ? EC_GK : EC_GQ) + h * 128 + 8 * cc) = v; } } } while (0)
#define SCAN_BAR() asm volatile("s_waitcnt lgkmcnt(0)\n\ts_barrier" ::: "memory")
#define SCAN_STEP(PFS, SET, n_, NWAIT) do { const int n = (n_); \
          \
        float gcl; \
        SCAN_BAR(); \
        scan_wait<GDN, FULL, NWAIT>(PFS); \
        if constexpr (GDN) { \
            { const LAS float* gsl = (const LAS float*)(L + SL_GCP) + (SET) * 64; gcl = gsl[63]; \
              if (tid < 64) { const float gc_ = gsl[tid]; EGS[tid] = __expf(gc_); DKS[tid] = __expf(gcl - gc_); } } \
            _Pragma("unroll") for (int k = 0; k < 2; ++k) { const int it = tid + 512 * k, pr = it >> 4, cc = it & 15; \
                if constexpr (FULL) st_perm8(QD + pr * S128, 8 * cc, PFS.q[k]); \
                st_perm8(WW + pr * S128, 8 * cc, PFS.w[k]); \
                *(LAS u32x4*)(UU + pr * S128 + 8 * cc) = PFS.u[k]; } \
            _Pragma("unroll") for (int k = 0; k < 2; ++k) { const int it = tid + 512 * k, dk = it >> 3, c8 = it & 7; \
                st_perm8(KDT + dk * S64, dir ? 56 - 8 * c8 : 8 * c8, dir ? rev8(PFS.k[k]) : PFS.k[k]); } \
            if constexpr (FULL) { const int pr = tid >> 3, c8 = tid & 7; st_perm8(AT + pr * S64, 8 * c8, PFS.a); } \
        } else { \
            gcl = 64.f * lg; \
            if (tid < 64) { EGS[tid] = __expf((float)(tid + 1) * lg); DKS[tid] = __expf((float)(63 - tid) * lg); } \
            { const int pr = tid >> 3, cc = tid & 7; \
                if constexpr (FULL) st_perm8(QD + pr * S64, 8 * cc, PFS.q[0]); \
                const u32x4 kd = scale8(PFS.k[0], 0.125f); \
                if constexpr (FULL) st_perm8(KNAT + pr * S64, 8 * cc, kd); \
                const unsigned w_[4] = {kd.x, kd.y, kd.z, kd.w}; \
                _Pragma("unroll") for (int e = 0; e < 4; ++e) { KDT[(8 * cc + 2 * e) * S64 + kperm(pr)] = (bf16_t)(w_[e] & 0xffffu); KDT[(8 * cc + 2 * e + 1) * S64 + kperm(pr)] = (bf16_t)(w_[e] >> 16); } } \
            _Pragma("unroll") for (int k = 0; k < 2; ++k) { const int it = tid + 512 * k, pr = it >> 4, cc = it & 15; *(LAS u32x4*)(UU + pr * S128 + 8 * cc) = PFS.u[k]; } \
        } \
        if constexpr (FULL) { if (n > 0) SCAN_STORE_O(CHUNK_OF(n - 1)); } \
        SCAN_BAR(); \
        scan_load<GDN, FULL>(PFS, ws, E, SO, dir, h, CHUNK_OF(n + 2 < ns ? n + 2 : ns - 1), gcbase + (SET) * 256); \
        if constexpr (!GDN && FULL) { \
            _Pragma("unroll") for (int e = 0; e < 2; ++e) { const int tt = 2 * wave + e, mt = tt >> 2, nt = tt & 3; \
                f32x4 acc = {0.f, 0.f, 0.f, 0.f}; \
                if (nt <= mt) { \
                    _Pragma("unroll") for (int s = 0; s < 2; ++s) acc = mfma16(*(const LAS bf16x8*)(QD + (16 * mt + fr) * S64 + 32 * s + 8 * g), *(const LAS bf16x8*)(KNAT + (16 * nt + fr) * S64 + 32 * s + 8 * g), acc); \
                } \
                _Pragma("unroll") for (int r = 0; r < 4; ++r) { const int i = 16 * mt + 4 * g + r, j = 16 * nt + fr; \
                    AT[i * S64 + kperm(j)] = f2bf(j <= i ? acc[r] * __expf((float)(i - j) * lg) : 0.f); } } \
            SCAN_BAR(); \
        } \
        { \
        const float cd = __expf(gcl); \
        bf16x8 Sb[NKS], Db[TRK ? NKS : 1]; \
        _Pragma("unroll") for (int s = 0; s < NKS; ++s) Sb[s] = pack8(S[2 * s], S[2 * s + 1]); \
        if constexpr (TRK) { _Pragma("unroll") for (int s = 0; s < NKS; ++s) Db[s] = pack8(D[2 * s], D[2 * s + 1]); } \
        f32x4 vn[4], oi[FULL ? 4 : 1], vd[TRK ? 4 : 1]; \
          \
        constexpr bool PFQ = FULL && !GDN;              \
        bf16x8 fq[PFQ ? NKS : 1], fw[GDN ? NKS : 1]; \
        if constexpr (PFQ) { _Pragma("unroll") for (int s = 0; s < NKS; ++s) fq[s] = afrag(QD, SQ, 0, s, fr, g); } \
        if constexpr (GDN) { _Pragma("unroll") for (int s = 0; s < NKS; ++s) fw[s] = afrag(WW, S128, 0, s, fr, g); } \
        _Pragma("unroll") for (int mt = 0; mt < 4; ++mt) { \
            bf16x8 nq[PFQ ? NKS : 1], nw[GDN ? NKS : 1]; \
            if (mt < 3) { if constexpr (PFQ) { _Pragma("unroll") for (int s = 0; s < NKS; ++s) nq[s] = afrag(QD, SQ, 16 * (mt + 1), s, fr, g); } \
                          if constexpr (GDN) { _Pragma("unroll") for (int s = 0; s < NKS; ++s) nw[s] = afrag(WW, S128, 16 * (mt + 1), s, fr, g); } } \
            f32x4 uu; \
            _Pragma("unroll") for (int r = 0; r < 4; ++r) uu[r] = bf2f(UU[(16 * mt + 4 * g + r) * S128 + col]); \
            asm volatile("" ::: "memory"); \
            if constexpr (FULL) { f32x4 o = {0.f, 0.f, 0.f, 0.f}; \
                _Pragma("unroll") for (int s = 0; s < NKS; ++s) o = mfma16(PFQ ? fq[s] : afrag(QD, SQ, 16 * mt, s, fr, g), Sb[s], o); \
                oi[mt] = o * *(const LAS f32x4*)(EGS + 16 * mt + 4 * g); } \
            if constexpr (GDN) { f32x4 t = {0.f, 0.f, 0.f, 0.f}, td = {0.f, 0.f, 0.f, 0.f}; \
                _Pragma("unroll") for (int s = 0; s < NKS; ++s) { t = mfma16(fw[s], Sb[s], t); if constexpr (TRK) td = mfma16(fw[s], Db[s], td); } \
                vn[mt] = uu - t; \
                if constexpr (TRK) { f32x4 wc_; _Pragma("unroll") for (int r = 0; r < 4; ++r) wc_[r] = bf2f(WW[(16 * mt + 4 * g + r) * S128 + kperm(col)]); vd[mt] = wc_ * (-crun) - td; } \
            } else vn[mt] = uu; \
            if (mt < 3) { if constexpr (PFQ) { _Pragma("unroll") for (int s = 0; s < NKS; ++s) fq[s] = nq[s]; } \
                          if constexpr (GDN) { _Pragma("unroll") for (int s = 0; s < NKS; ++s) fw[s] = nw[s]; } } \
        } \
        bf16x8 vb[FULL ? 2 : 1], vk[2], vkd[TRK ? 2 : 1]; \
        if constexpr (FULL) { vb[0] = pack8(vn[0], vn[1]); vb[1] = pack8(vn[2], vn[3]); } \
        _Pragma("unroll") for (int s = 0; s < 2; ++s) { const f32x4 d0 = *(const LAS f32x4*)(DKS + 32 * s + 4 * g), d1 = *(const LAS f32x4*)(DKS + 32 * s + 16 + 4 * g); \
            vk[s] = pack8(vn[2 * s] * d0, vn[2 * s + 1] * d1); if constexpr (TRK) vkd[s] = pack8(vd[2 * s] * d0, vd[2 * s + 1] * d1); } \
        if constexpr (FULL) { \
        _Pragma("unroll") for (int mt = 0; mt < 4; ++mt) { \
            f32x4 o = oi[mt]; \
            _Pragma("unroll") for (int s = 0; s < 2; ++s) o = mfma16(afrag(AT, S64, 16 * mt, s, fr, g), vb[s], o); \
            _Pragma("unroll") for (int r = 0; r < 4; ++r) OO[(16 * mt + 4 * g + r) * S128 + col] = f2bf(o[r]); \
        } } \
        _Pragma("unroll") for (int dt = 0; dt < NDT; ++dt) { f32x4 t = S[dt] * cd; f32x4 td; if constexpr (TRK) td = D[dt] * cd; \
            _Pragma("unroll") for (int s = 0; s < 2; ++s) { const bf16x8 kf = afrag(KDT, S64, 16 * dt, s, fr, g); t = mfma16(kf, vk[s], t); if constexpr (TRK) td = mfma16(kf, vkd[s], td); } \
            S[dt] = t; if constexpr (TRK) D[dt] = td; if ((dt & 3) == 3) asm volatile("" ::: "memory"); } \
        crun *= cd; \
        } } while (0)
    ScanPF PA, PB;
    const unsigned gcbase = (unsigned)(uintptr_t)(L + SL_GCP);
    ScanOff SO; scan_offsets<GDN>(SO, tid, dir, h);
    scan_load<GDN, FULL>(PA, ws, E, SO, dir, h, CHUNK_OF(0), gcbase);
    scan_load<GDN, FULL>(PB, ws, E, SO, dir, h, CHUNK_OF(1), gcbase + 256);
    constexpr int NL = GDN ? (FULL ? 10 : 7) : (FULL ? 4 : 3), NS = FULL ? 2 : 0;
    SCAN_STEP(PA, 0, 0, NL); SCAN_STEP(PB, 1, 1, NL);
#pragma unroll 1
    for (int nn = 2; nn < ns; nn += 2) { SCAN_STEP(PA, 0, nn, NL + NS); SCAN_STEP(PB, 1, nn + 1, NL + NS); }
    scan_wait<GDN, FULL, 0>(PA); scan_wait<GDN, FULL, 0>(PB);
    __syncthreads();
    lane = fresh_lane(); tid = wave * 64 + lane; g = lane >> 4; fr = lane & 15; col = 16 * wave + fr;
    if constexpr (FULL) SCAN_STORE_O(CHUNK_OF(ns - 1));
    if constexpr (MODE == 0) { float* so = as_global(P.out) + (GDN ? OUT_SGDN : OUT_SRET) + (size_t)((seq * 2 + dir) * 4 + h) * DK * 128;
#pragma unroll
        for (int dt = 0; dt < NDT; ++dt)
#pragma unroll
            for (int r = 0; r < 4; ++r) so[(16 * dt + 4 * g + r) * 128 + col] = S[dt][r]; }
    if constexpr (MODE == 1) {
#pragma unroll
        for (int dt = 0; dt < NDT; ++dt)
#pragma unroll
            for (int r = 0; r < 4; ++r) sgb[(16 * dt + 4 * g + r) * 128 + col] = S[dt][r];
        if constexpr (TRK) { bf16_t* dl = (bf16_t*)(ws + WS_DLT) + ((size_t)ci * SNG + gi) * 16384;
#pragma unroll
            for (int dt = 0; dt < NDT; ++dt)
#pragma unroll
                for (int r = 0; r < 4; ++r) dl[(16 * dt + 4 * g + r) * 128 + kperm(col)] = f2bf(D[dt][r]);
            if (tid == 0) ((float*)(ws + WS_CG))[ci * SNG + gi] = crun; }
    }
#undef SCAN_STEP
#undef SCAN_STORE_O
#undef CHUNK_OF
}
__device__ __forceinline__ void run_ctx_chain(const Frame& F, const Params& P, unsigned char* ws, int c, bool dummy) {
    const bool gdn = c < 128; const int idx = gdn ? c : c - 128;
    if (gdn) scan_unit<true, 0>(F, P, ws, idx >> 3, (idx >> 1) & 3, idx & 1, 0, dummy);
    else scan_unit<false, 0>(F, P, ws, idx >> 3, (idx >> 1) & 3, idx & 1, 0, dummy);
}
__device__ __forceinline__ void phase_scan1(const Frame& F, const Params& P, unsigned char* ws) {
#pragma unroll 1
    for (int u = F.bid; u < 64 * SNG; u += F.nb) { const int ci = (u / SNG) & 31, gi = u % SNG;
        if (gi == SNG - 1) continue;
        if (u < 32 * SNG) scan_unit<true, 1>(F, P, ws, ci >> 3, (ci >> 1) & 3, ci & 1, gi, false);
        else scan_unit<false, 1>(F, P, ws, ci >> 3, (ci >> 1) & 3, ci & 1, gi, false); }
    if (F.nb == 64 * SNG && SNG == 4) {
        const int u = F.bid, gi = u & 3;
        int c0 = 0, nc = 0;
        if (gi == 3) { c0 = 2 * (u >> 2); nc = 2; }
        else if (u >= 128) { c0 = 128 + 3 * ((u - 128) >> 2) + gi; nc = 1; }
#pragma unroll 1
        for (int t = 0; t < nc; ++t) run_ctx_chain(F, P, ws, c0 + t, false);
    }
}
__device__ __forceinline__ void phase_scan(const Frame& F, const Params& P, unsigned char* ws, bool dummy) {
#pragma unroll 1
    for (int u = F.bid; u < 64 * SNG; u += F.nb) { const int ci = (u / SNG) & 31, gi = u % SNG;
        if (u < 32 * SNG) scan_unit<true, 3>(F, P, ws, ci >> 3, (ci >> 1) & 3, ci & 1, gi, dummy);
        else scan_unit<false, 3>(F, P, ws, ci >> 3, (ci >> 1) & 3, ci & 1, gi, dummy); }
    int c0 = F.bid, c1 = 256, cs = F.nb;
    if (F.nb == 64 * SNG && SNG == 4) {
        const int u = F.bid;
        if (u >= 128 && (u & 3) == 0) { c0 = 224 + ((u - 128) >> 2); c1 = c0 + 1; } else { c0 = 256; }
    }
#pragma unroll 1
    for (int c = c0; c < c1; c += cs) run_ctx_chain(F, P, ws, c, dummy);
    if (F.nb == 64 * SNG && SNG == 4 && !dummy) {
        const int u = F.bid;
        if (u >= 128 && (u & 3) != 0) { __syncthreads(); Frame G = F; G.gw = (3 * ((u - 128) >> 2) + (u & 3) - 1) * 8 + F.wave; G.ngw = 96 * 8; conv_l0_half(G, P, 1, ws); conv_l1_a2(G, P, ws); }
    }
}

__device__ __forceinline__ void combine_half(u32x4 of, u32x4 ob, u32x4 gt, const f32x4 w0, const f32x4 w1, bf16_t* dst) {
    float o[8] = {bflo(of.x) + bflo(ob.x), bfhi(of.x) + bfhi(ob.x), bflo(of.y) + bflo(ob.y), bfhi(of.y) + bfhi(ob.y), bflo(of.z) + bflo(ob.z), bfhi(of.z) + bfhi(ob.z), bflo(of.w) + bflo(ob.w), bfhi(of.w) + bfhi(ob.w)};
    const float gv[8] = {bflo(gt.x), bfhi(gt.x), bflo(gt.y), bfhi(gt.y), bflo(gt.z), bfhi(gt.z), bflo(gt.w), bfhi(gt.w)};
    float ss = 0.f;
#pragma unroll
    for (int e = 0; e < 8; ++e) ss += o[e] * o[e];
    ss = row16_sum(ss);
    const float rs = 1.0f / sqrtf(ss * (1.f / 128.f) + EPS);
    const float wv[8] = {w0.x, w0.y, w0.z, w0.w, w1.x, w1.y, w1.z, w1.w};
    float y[8];
#pragma unroll
    for (int e = 0; e < 8; ++e) y[e] = o[e] * rs * wv[e] * silu_f(gv[e]);
    *(u32x4*)dst = (u32x4){pk2(y[0], y[1]), pk2(y[2], y[3]), pk2(y[4], y[5]), pk2(y[6], y[7])};
}
__device__ __forceinline__ void phase_combine(const Frame& F, const Params& P, unsigned char* ws) {
    const bf16_t* E = (const bf16_t*)(ws + WS_BIG); const bf16_t* U = (const bf16_t*)(ws + WS_U); bf16_t* MIX = (bf16_t*)(ws + WS_XN);
    const int hh = F.lane >> 4, c0 = 8 * (F.lane & 15);
    const f32x4 rw0 = *(const f32x4*)(as_global(P.ret_norm_w) + c0), rw1 = *(const f32x4*)(as_global(P.ret_norm_w) + c0 + 4);
    const f32x4 gw0 = *(const f32x4*)(as_global(P.gdn_norm_w) + c0), gw1 = *(const f32x4*)(as_global(P.gdn_norm_w) + c0 + 4);
#define COMB_LD(v, r, m_) do { const int m = (m_), chunk = m >> 6, p = m & 63; const bf16_t* er = E + (size_t)m * EVN + hh * 128 + c0; \
            v[r][0] = *(const u32x4*)(er + EC_GQ); v[r][1] = *(const u32x4*)(er + EC_GK); v[r][2] = *(const u32x4*)(er + EC_RG); \
            v[r][3] = *(const u32x4*)(U + ((size_t)(0 * NCHUNK + chunk) * 4 + hh) * 8192 + p * 128 + c0); v[r][4] = *(const u32x4*)(U + ((size_t)(1 * NCHUNK + chunk) * 4 + hh) * 8192 + (63 - p) * 128 + c0); \
            v[r][5] = *(const u32x4*)(er + EC_GG); } while (0)
#define COMB_FIN(v, r, m_) do { const int m = (m_); combine_half(v[r][0], v[r][1], v[r][2], rw0, rw1, MIX + (size_t)m * 1024 + hh * 128 + c0); \
            combine_half(v[r][3], v[r][4], v[r][5], gw0, gw1, MIX + (size_t)m * 1024 + 512 + hh * 128 + c0); } while (0)
#define COMB_W3(v) asm volatile("" :: "v"(v[0][0]), "v"(v[0][1]), "v"(v[0][2]), "v"(v[0][3]), "v"(v[0][4]), "v"(v[0][5]), "v"(v[1][0]), "v"(v[1][1]), "v"(v[1][2]), "v"(v[1][3]), "v"(v[1][4]), "v"(v[1][5]), \
                     "v"(v[2][0]), "v"(v[2][1]), "v"(v[2][2]), "v"(v[2][3]), "v"(v[2][4]), "v"(v[2][5]) : "memory")
#define COMB_W2(v) asm volatile("" :: "v"(v[0][0]), "v"(v[0][1]), "v"(v[0][2]), "v"(v[0][3]), "v"(v[0][4]), "v"(v[0][5]), "v"(v[1][0]), "v"(v[1][1]), "v"(v[1][2]), "v"(v[1][3]), "v"(v[1][4]), "v"(v[1][5]) : "memory")
    if (F.gw + 9 * F.ngw < MROWS && F.gw + 10 * F.ngw >= MROWS) {
        const int g0 = F.gw, st = F.ngw;
        u32x4 va[3][6], vb[3][6];
        COMB_LD(va, 0, g0); COMB_LD(va, 1, g0 + st); COMB_LD(va, 2, g0 + 2 * st);
        COMB_LD(vb, 0, g0 + 3 * st); COMB_LD(vb, 1, g0 + 4 * st); COMB_LD(vb, 2, g0 + 5 * st);
        COMB_W3(va); COMB_FIN(va, 0, g0); COMB_FIN(va, 1, g0 + st); COMB_FIN(va, 2, g0 + 2 * st);
        COMB_LD(va, 0, g0 + 6 * st); COMB_LD(va, 1, g0 + 7 * st); asm volatile("" ::: "memory");
        COMB_W3(vb); COMB_FIN(vb, 0, g0 + 3 * st); COMB_FIN(vb, 1, g0 + 4 * st); COMB_FIN(vb, 2, g0 + 5 * st);
        COMB_LD(vb, 0, g0 + 8 * st); COMB_LD(vb, 1, g0 + 9 * st); asm volatile("" ::: "memory");
        COMB_W2(va); COMB_FIN(va, 0, g0 + 6 * st); COMB_FIN(va, 1, g0 + 7 * st);
        COMB_W2(vb); COMB_FIN(vb, 0, g0 + 8 * st); COMB_FIN(vb, 1, g0 + 9 * st);
        return;
    }
#undef COMB_W2
#undef COMB_W3
#undef COMB_FIN
#undef COMB_LD
    for (int m0 = F.gw; m0 < MROWS; m0 += 4 * F.ngw) {
        u32x4 v[4][6]; int mr[4];
#pragma unroll
        for (int r = 0; r < 4; ++r) { const int mm = m0 + r * F.ngw; const int m = mm < MROWS ? mm : m0; mr[r] = mm < MROWS ? mm : -1; const int chunk = m >> 6, p = m & 63;
            const bf16_t* er = E + (size_t)m * EVN + hh * 128 + c0;
            v[r][0] = *(const u32x4*)(er + EC_GQ); v[r][1] = *(const u32x4*)(er + EC_GK); v[r][2] = *(const u32x4*)(er + EC_RG);
            v[r][3] = *(const u32x4*)(U + ((size_t)(0 * NCHUNK + chunk) * 4 + hh) * 8192 + p * 128 + c0); v[r][4] = *(const u32x4*)(U + ((size_t)(1 * NCHUNK + chunk) * 4 + hh) * 8192 + (63 - p) * 128 + c0);
            v[r][5] = *(const u32x4*)(er + EC_GG); }
        asm volatile("" :: "v"(v[0][0]), "v"(v[0][1]), "v"(v[0][2]), "v"(v[0][3]), "v"(v[0][4]), "v"(v[0][5]), "v"(v[1][0]), "v"(v[1][1]), "v"(v[1][2]), "v"(v[1][3]), "v"(v[1][4]), "v"(v[1][5]),
                     "v"(v[2][0]), "v"(v[2][1]), "v"(v[2][2]), "v"(v[2][3]), "v"(v[2][4]), "v"(v[2][5]), "v"(v[3][0]), "v"(v[3][1]), "v"(v[3][2]), "v"(v[3][3]), "v"(v[3][4]), "v"(v[3][5]) : "memory");
#pragma unroll
        for (int r = 0; r < 4; ++r) { const int m = mr[r]; if (m < 0) continue;
            combine_half(v[r][0], v[r][1], v[r][2], rw0, rw1, MIX + (size_t)m * 1024 + hh * 128 + c0);
            combine_half(v[r][3], v[r][4], v[r][5], gw0, gw1, MIX + (size_t)m * 1024 + 512 + hh * 128 + c0); }
    }
}
__device__ __forceinline__ void conv_l1_a1(const Frame& F, const Params& P, unsigned char* ws) {
    LAS float* scr = (LAS float*)(F.lds + F.wave * 16384);
    conv_swiglu(F, as_global(P.ffn_w_in) + (size_t)(1 * 2 + 0) * DM * FF2, (bf16_t*)(ws + WS_WFIN0), scr);
    conv_plain(F, as_global(P.ffn_w_out) + (size_t)(1 * 2 + 0) * FFH * DM, FFH, DM, DM, (bf16_t*)(ws + WS_WFOUT0), scr, true);
}
__device__ __forceinline__ void conv_l1_b1(const Frame& F, const Params& P, unsigned char* ws) {
    LAS float* scr = (LAS float*)(F.lds + F.wave * 16384);
    conv_swiglu(F, as_global(P.ffn_w_in) + (size_t)(1 * 2 + 1) * DM * FF2, (bf16_t*)(ws + WS_WFIN1), scr);
}
__device__ __forceinline__ void conv_l1_b2(const Frame& F, const Params& P, unsigned char* ws) {
    LAS float* scr = (LAS float*)(F.lds + F.wave * 16384);
    conv_plain(F, as_global(P.ffn_w_out) + (size_t)(1 * 2 + 1) * FFH * DM, FFH, DM, DM, (bf16_t*)(ws + WS_WFOUT1), scr, true);
}
__device__ __forceinline__ void conv_odd_out(const Frame& F, const Params& P, unsigned char* ws) {
    LAS float* scr = (LAS float*)(F.lds + F.wave * 16384);
    conv_plain(F, as_global(P.odd_w_out), DM, DM, DM, (bf16_t*)(ws + WS_WMOUT), scr);
}
__device__ __forceinline__ void phase_conv_l1(const Frame& F, const Params& P, unsigned char* ws) {
    if (F.nb != 256) { conv_l1_a1(F, P, ws); conv_l1_a2(F, P, ws); conv_l1_b1(F, P, ws); conv_l1_b2(F, P, ws); }
    if (F.nb != 256) conv_odd_out(F, P, ws);
}
__device__ __forceinline__ void conv_cache_kv(const Params& P, unsigned char* ws, int gt, int ngt) {
    bf16_t* KL = (bf16_t*)(ws + WS_KL); bf16_t* VL = (bf16_t*)(ws + WS_VL);
    const float* ck = as_global(P.cache_k); const float* cv = as_global(P.cache_v);
    for (int i = gt; i < 4 * 512 * 256 / 8; i += ngt) {
        const int b = i >> 14, rem = i & 16383;
        const f32x4 k0 = *(const f32x4*)(ck + (size_t)i * 8), k1 = *(const f32x4*)(ck + (size_t)i * 8 + 4);
        const f32x4 v0 = *(const f32x4*)(cv + (size_t)i * 8), v1 = *(const f32x4*)(cv + (size_t)i * 8 + 4);
        *(u32x4*)(KL + (size_t)b * 4608 * 256 + (size_t)rem * 8) = (u32x4){pk2(k0.x, k0.y), pk2(k0.z, k0.w), pk2(k1.x, k1.y), pk2(k1.z, k1.w)};
        *(u32x4*)(VL + (size_t)b * 4608 * 256 + (size_t)rem * 8) = (u32x4){pk2(v0.x, v0.y), pk2(v0.z, v0.w), pk2(v1.x, v1.y), pk2(v1.z, v1.w)};
    }
}
constexpr int NTHREADS = 512, LDS_BYTES = 163840;
#ifndef PROBE
#define PROBE 0
#endif
#ifndef PREP_SKIP
#define PREP_SKIP 13
#endif
#ifndef DBG_STOP
#define DBG_STOP 99
#endif

__device__ __forceinline__ void attention_phase(const Frame& F, const Params& P, unsigned char* ws, char* lds, size_t o_off) {
    using abf = attn_body::bf16;
    const abf* QS = (const abf*)(ws + WS_BIG); abf* O = (abf*)(ws + o_off);
    const float* qnw = as_global(P.q_norm_w); const float* rope = (const float*)(ws + WS_ROPE);
    for (int k = 0; k < 4; ++k) {
        const int u = F.bid + F.nb * k; if (u >= 1024) break;
        const int b = u >> 8, h = (u >> 4) & 15, qb = u & 15;
        const size_t r0 = (size_t)NPR + (size_t)b * 4096 + 256 * qb;
        const abf* kh = (const abf*)(ws + WS_KL) + (size_t)b * 4608 * 256 + (h >> 2) * 64; const abf* vh = (const abf*)(ws + WS_VL) + (size_t)b * 4608 * 256 + (h >> 2) * 64;
        attn_body::attn_unit<8>(QS + r0 * 1536 + h * 64, kh, vh, O + r0 * 1024 + h * 64, 72, lds, F.wave, qnw, rope, 256 * qb);
    }
    for (int u = F.bid; u < 256; u += F.nb) {
        const int b = u >> 4, h = u & 15;
        const size_t r0 = (size_t)b * 256;
        const abf* kh = (const abf*)(ws + WS_KP) + (size_t)b * 256 * 256 + (h >> 2) * 64; const abf* vh = (const abf*)(ws + WS_VP) + (size_t)b * 256 * 256 + (h >> 2) * 64;
        attn_body::attn_unit<8>(QS + r0 * 1536 + h * 64, kh, vh, O + r0 * 1024 + h * 64, 4, lds, F.wave, qnw, rope, -1);
    }
}

__device__ __forceinline__ int opaque_u(int v) { v = __builtin_amdgcn_readfirstlane(v); asm volatile("" : "+s"(v)); return v; }
__device__ __forceinline__ unsigned char* opaque_ptr(unsigned char* p) {
    unsigned lo = __builtin_amdgcn_readfirstlane((unsigned)(uintptr_t)p), hi = __builtin_amdgcn_readfirstlane((unsigned)((uintptr_t)p >> 32));
    asm volatile("" : "+s"(lo), "+s"(hi));
    return as_global((unsigned char*)(((uintptr_t)hi << 32) | (uintptr_t)lo));
}
template <class Epi>
__device__ __forceinline__ void run_gemm(const Frame& F, const bf16_t* A, const bf16_t* Bt, int N, int K, const Epi& E) {
    pg8::Gemm g{A, Bt, MROWS, N, K, false}; pg8::StaticOrder S; S.init(MROWS, N, K, F.nb, F.bid);
    pg8::gemm_phase<Epi, pg8::StaticOrder, true, true>(F.lds, g, S, E, F.wave);
}
__device__ __forceinline__ void run_gemm_ts(const Frame& F, const bf16_t* A, const bf16_t* Bt, int K, const pg8::EpiResid E, const bool tiled = false) {
    pg8::Gemm g{A, Bt, MROWS, DM, K, tiled}; pg8::TailSplit S; S.init(MROWS, DM, K, F.nb, F.bid);
    pg8::gemm_phase<pg8::EpiResid, pg8::TailSplit, true, true>(F.lds, g, S, E, F.wave);
}

__global__ void __launch_bounds__(NTHREADS, 2) mega_fwd(Params PA) {
    extern __shared__ __attribute__((aligned(16))) unsigned char lds[];
    Frame F; F.lds = (LAS unsigned char*)lds; F.wave = __builtin_amdgcn_readfirstlane((int)threadIdx.x >> 6); F.lane = fresh_lane(); F.tid = F.wave * 64 + F.lane;
    F.bid = blockIdx.x; F.nb = gridDim.x; F.gw = F.bid * 8 + F.wave; F.ngw = F.nb * 8;
    unsigned char* ws = PA.ws;
    float* X = PA.out;
    if (F.tid == 0) *(Params*)(ws + WS_PTAB) = PA;
    const Params* pt = (const Params*)opaque_ptr(ws + WS_PTAB);
    const Params& P = *pt;
    const float* MOD = (const float*)(ws + WS_MOD);
    bf16_t* XN = (bf16_t*)(ws + WS_XN); bf16_t* BIG = (bf16_t*)(ws + WS_BIG);
    volatile LAS unsigned* bst = (volatile LAS unsigned*)(F.lds + LDS_BYTES - 64);
    if (F.tid < 2) bst[F.tid] = 0u;
    __syncthreads();
    const unsigned bar_x = xcd_barrier_post((unsigned*)(ws + WS_CTL), bst, F.tid == 0).x;
#define SYNC() do { { XcdBarrier b_; b_.bar = (unsigned*)(ws + WS_CTL); b_.x = (unsigned)opaque_u((int)bar_x); b_.st = bst; xcd_barrier(b_, F.tid == 0); } F.bid = opaque_u(F.bid); F.wave = opaque_u(F.wave); ws = opaque_ptr(ws); X = (float*)opaque_ptr((unsigned char*)X); F.lane = fresh_lane(); F.tid = F.wave * 64 + F.lane; F.gw = F.bid * 8 + F.wave; } while (0)
#define STOP(k) do { if (DBG_STOP == (k)) return; } while (0)

_Pragma("unroll 1") for (int rep = 0; rep < (PROBE == 15 ? 2 : 1); ++rep) {
    phase_p0(F, PA, ws); SYNC(); STOP(0);
    }
    bf16_t* SLAB = (bf16_t*)(ws + WS_SLAB); const bf16_t* fslab = (F.nb == 256) ? SLAB : nullptr;
#pragma unroll 1
    for (int l = 0; l < 2; ++l) {
        const float* modl = MOD + (size_t)l * 5 * 9216;
#pragma unroll 1
        for (int half = 0; half < 2; ++half) {
            const bool first = (l == 0 && half == 0);
            const float* xp = first ? as_global(P.x_prompt) : X; const float* xs = first ? as_global(P.x_sample) : X + (size_t)NPR * 1024;
            phase_norm(F, P, ws, xp, xs, xs, l, 2 * half, first ? (const bf16_t*)nullptr : fslab, half == 0 ? MOD : modl, 8 - 3 * half, half == 0 ? 0.5f : 1.0f);
            if (l == 1 && half == 0 && F.nb != 256) { __syncthreads(); phase_conv_l1(F, P, ws); }
            SYNC();
_Pragma("unroll 1") for (int rep = 0; rep < (PROBE == 1 ? 2 : 1); ++rep) {
            run_gemm(F, XN, (const bf16_t*)(ws + (half ? WS_WFIN1 : WS_WFIN0)), FF2, DM, pg8::EpiSwiGLU{BIG, FFH});
            if ((half == 0 || l == 0) && F.nb == 256 && F.bid >= 224) { __syncthreads(); Frame G = F; G.gw = (F.bid - 224) * 8 + F.wave; G.ngw = 32 * 8;
                if (half == 1) conv_odd_out(G, P, ws); else if (l == 1) conv_l1_b1(G, P, ws); else { conv_l0_out(G, P, 0, ws); conv_even_in(G, P, ws); } }
            SYNC();
            }
_Pragma("unroll 1") for (int rep = 0; rep < (PROBE == 2 ? 2 : 1); ++rep) {
            run_gemm_ts(F, BIG, (const bf16_t*)(ws + (half ? WS_WFOUT1 : WS_WFOUT0)), FFH, pg8::EpiResid{xp, xs, X, modl, SLAB, 2 + 6 * half, 0.5f}, true);
            SYNC();
            }
            if (first) STOP(1);
            if (half == 1) break;
_Pragma("unroll 1") for (int rep = 0; rep < ((PROBE == 12 && l == 0) ? 2 : 1); ++rep) {
            if (l == 0) phase_norm_gates(F, P, ws, X, X + (size_t)NPR * 1024, fslab ? xs : X + (size_t)NPR * 1024, fslab, modl, 2, 0.5f);
            else phase_norm(F, P, ws, X, X + (size_t)NPR * 1024, fslab ? xs : X + (size_t)NPR * 1024, l, 1, fslab, modl, 2, 0.5f);
            SYNC();
            }
            if (l == 0) {
                run_gemm(F, XN, (const bf16_t*)(ws + WS_WMIN), EVN, DM, pg8::EpiBf16{BIG, EVN});
                if (F.nb == 256 && F.bid >= 96) { __syncthreads(); Frame G = F; G.gw = (F.bid - 96) * 8 + F.wave; G.ngw = 160 * 8; conv_l1_a1(G, P, ws); conv_even_out(G, P, ws); __syncthreads(); phase_mod<false>(F, P, ws, 72, 144, F.bid - 96, 160); }
            } else {
                LAS float* rtl = (LAS float*)(F.lds + 131072);
                { const float* RT = (const float*)(ws + WS_ROPE); for (int i = F.tid; i < 2048; i += 512) rtl[i] = RT[i]; if (F.tid < 64) rtl[2048 + F.tid] = as_global(P.k_norm_w)[F.tid]; }
                __syncthreads();
                run_gemm(F, XN, (const bf16_t*)(ws + WS_WMIN), ODN, DM, pg8::EpiOddIn{BIG, ws, X, rtl});
                if (F.nb == 256 && F.bid >= 224) { __syncthreads(); Frame G = F; G.gw = (F.bid - 224) * 8 + F.wave; G.ngw = 32 * 8; conv_l1_b2(G, P, ws); conv_cache_kv(P, ws, G.gw * 64 + F.lane, G.ngw * 64); }
                else if (F.nb != 256) conv_cache_kv(P, ws, F.gw * 64 + F.lane, F.ngw * 64);
            }
            SYNC();
            if (l == 0) {
_Pragma("unroll 1") for (int rep = 0; rep < (PROBE == 4 ? 2 : 1); ++rep) {
_Pragma("unroll 1") for (int rep2 = 0; rep2 < (PROBE == 3 ? 2 : 1); ++rep2) {
                phase_gdn_prep(F, P, ws, (PROBE == 3 && rep2 == 0) ? PREP_SKIP : 0); SYNC();
                }
                phase_scan1(F, P, ws); SYNC();
_Pragma("unroll 1") for (int rep3 = (PROBE == 8 ? 0 : 1); rep3 < 2; ++rep3) {
                phase_scan(F, P, ws, rep3 == 0); SYNC(); STOP(2);
                }
                }
_Pragma("unroll 1") for (int rep = 0; rep < (PROBE == 13 ? 2 : 1); ++rep) {
                phase_combine(F, P, ws); SYNC();
                }
            } else {
_Pragma("unroll 1") for (int rep = (PROBE == 6 ? 0 : 1); rep < 2; ++rep) {
                attention_phase(F, P, ws, (char*)lds, WS_Q); SYNC();
                }
            }
            run_gemm_ts(F, l == 0 ? XN : (const bf16_t*)(ws + WS_Q), (const bf16_t*)(ws + WS_WMOUT), DM, pg8::EpiResid{X, X + (size_t)NPR * 1024, X, modl, SLAB, 5, 1.0f}); SYNC();
        }
    }
    phase_final(F, P, fslab, MOD + (size_t)1 * 5 * 9216, 8, 0.5f);
}

extern "C" void kernel_launch(void* const* d_in, const int* in_sizes, int n_in, void* d_out, int out_size, void* d_ws, size_t ws_size, hipStream_t stream) {
    static int grid = 0;
    if (grid == 0) {
        if (n_in != 26 || (size_t)out_size != OUT_END || ws_size < WS_END) { fprintf(stderr, "kernel_launch: unexpected problem (n_in %d, out %d, ws %zu)\n", n_in, out_size, ws_size); grid = -1; return; }
        int dev = 0, cus = 0, per_cu = 0;
        hipGetDevice(&dev); hipDeviceGetAttribute(&cus, hipDeviceAttributeMultiprocessorCount, dev);
        if (hipFuncSetAttribute((const void*)mega_fwd, hipFuncAttributeMaxDynamicSharedMemorySize, LDS_BYTES) != hipSuccess) { fprintf(stderr, "kernel_launch: hipFuncSetAttribute failed\n"); grid = -1; return; }
        if (hipOccupancyMaxActiveBlocksPerMultiprocessor(&per_cu, (const void*)mega_fwd, NTHREADS, LDS_BYTES) != hipSuccess || per_cu < 1) { fprintf(stderr, "kernel_launch: occupancy query says %d\n", per_cu); per_cu = 1; }
        (void)hipGetLastError();
        grid = cus;
        fprintf(stderr, "kernel_launch: grid %d (occupancy query %d per CU), ws %zu\n", grid, per_cu, ws_size);
    }
    if (grid < 0) return;
    if (hipMemsetAsync((char*)d_ws + WS_CTL, 0, 65536, stream) != hipSuccess) { fprintf(stderr, "kernel_launch: memset failed\n"); return; }
    Params p{};
    const float** pp = (const float**)&p;
    for (int i = 0; i < 26; ++i) pp[i] = (const float*)d_in[i];
    p.out = (float*)d_out; p.ws = (unsigned char*)d_ws;
    void* args[] = {&p};
    hipError_t e = hipLaunchCooperativeKernel((const void*)mega_fwd, dim3(grid), dim3(NTHREADS), args, LDS_BYTES, stream);
    if (e != hipSuccess) fprintf(stderr, "cooperative launch failed: %s (grid %d)\n", hipGetErrorString(e), grid);
}
```

```cpp
#include <hip/hip_runtime.h>
#include <hip/hip_cooperative_groups.h>
#include <hip/hip_bf16.h>
#include <cstdint>
#include <cstdio>
#include <cmath>
namespace cg = cooperative_groups;

#define LAS __attribute__((address_space(3)))
typedef unsigned short bf16_t;
typedef short bf16x8 __attribute__((ext_vector_type(8)));
typedef short s16x4 __attribute__((ext_vector_type(4)));
typedef float f32x4 __attribute__((ext_vector_type(4)));
typedef float f32x2 __attribute__((ext_vector_type(2)));
typedef unsigned u32x4 __attribute__((ext_vector_type(4)));
typedef unsigned u32x2 __attribute__((ext_vector_type(2)));

constexpr int DM = 1024, NPR = 4096, NLA = 16384, MROWS = 20480, FFH = 2816, FF2 = 5632;
constexpr int EVN = 3584;
constexpr int EVFULL = 3600, ODN = 1536;
constexpr int NCHUNK = MROWS / 64;
constexpr float EPS = 1e-6f;
constexpr float LOG2E = 1.4426950408889634f;
constexpr float ATT_C2 = 0.125f * 1.4426950408889634f;

constexpr size_t OUT_Y = 0, OUT_SRET = (size_t)MROWS * DM, OUT_SGDN = OUT_SRET + 16 * 2 * 4 * 64 * 128,
                 OUT_CK = OUT_SGDN + 16 * 2 * 4 * 128 * 128, OUT_CV = OUT_CK + 16 * 256 * 256, OUT_END = OUT_CV + 16 * 256 * 256;

constexpr size_t MiB = 1u << 20;
constexpr size_t WS_CTL = 0;
constexpr size_t WS_MOD = 1 * MiB;
constexpr size_t WS_PTAB = 1 * MiB + 448 * 1024;
constexpr size_t WS_ROPE = 1 * MiB + 512 * 1024;
constexpr size_t WS_GW = 1 * MiB + 768 * 1024;
constexpr size_t WS_WFIN0 = 2 * MiB, WS_WFOUT0 = 13 * MiB, WS_WFIN1 = 18 * MiB + 512 * 1024, WS_WFOUT1 = 29 * MiB + 512 * 1024,
                 WS_WMIN = 35 * MiB, WS_WMOUT = 42 * MiB;
constexpr size_t WS_XN = 44 * MiB;
constexpr size_t WS_QN = WS_XN, WS_KNT = WS_XN + 20 * MiB;
constexpr size_t WS_BIG = 84 * MiB;
constexpr size_t WS_U = 224 * MiB, WS_W = 264 * MiB;
constexpr size_t WS_ATT = 304 * MiB;
constexpr size_t WS_GC = 324 * MiB;
constexpr size_t WS_GATES = 336 * MiB;
constexpr size_t WS_END = 352 * MiB;
constexpr size_t WS_Q = 224 * MiB;
constexpr size_t WS_KL = 264 * MiB, WS_VL = 273 * MiB;
constexpr size_t WS_KP = 282 * MiB, WS_VP = 284 * MiB;
constexpr size_t WS_SLAB = 265 * MiB;

struct Params {
    const float *x_prompt, *x_sample, *state_ret, *state_gdn, *cache_k, *cache_v, *c, *c_ctx, *mod_w, *mod_b, *norm_w, *ffn_w_in, *ffn_w_out,
        *even_w_in, *even_w_out, *ret_decay_logit, *ret_norm_w, *gdn_conv_w, *gdn_A_log, *gdn_dt_bias, *gdn_norm_w, *odd_w_in, *odd_w_out,
        *q_norm_w, *k_norm_w, *final_norm_w;
    float* out; unsigned char* ws;
};

template <class T> __device__ __forceinline__ T* as_global(T* p) { return (T*)(__attribute__((address_space(1))) T*)(uintptr_t)p; }
__device__ __forceinline__ float bf2f(unsigned short b) { return __uint_as_float((unsigned)b << 16); }
__device__ __forceinline__ float bflo(unsigned w) { return __uint_as_float(w << 16); }
__device__ __forceinline__ float bfhi(unsigned w) { return __uint_as_float(w & 0xffff0000u); }
typedef __bf16 bf16x2_t __attribute__((ext_vector_type(2)));
__device__ __forceinline__ unsigned pk2(float lo, float hi) { f32x2 v = {lo, hi}; bf16x2_t b = __builtin_convertvector(v, bf16x2_t); return __builtin_bit_cast(unsigned, b); }
__device__ __forceinline__ unsigned short f2bf(float f) { return (unsigned short)(pk2(f, 0.f) & 0xffffu); }
__device__ __forceinline__ int fresh_lane() { int z; asm volatile("s_mov_b32 %0, 0" : "=s"(z)); return (int)__builtin_amdgcn_mbcnt_hi(~0u, __builtin_amdgcn_mbcnt_lo(~0u, (unsigned)z)); }
__device__ __forceinline__ float shx(float v, int o, int lane) { return __builtin_bit_cast(float, __builtin_amdgcn_ds_bpermute((lane ^ o) << 2, __builtin_bit_cast(int, v))); }
__device__ __forceinline__ float dpp_add(float v, const int ctrl_sel) {
    int t;
    if (ctrl_sel == 0) t = __builtin_amdgcn_update_dpp(0, __builtin_bit_cast(int, v), 0xB1, 0xF, 0xF, false);
    else if (ctrl_sel == 1) t = __builtin_amdgcn_update_dpp(0, __builtin_bit_cast(int, v), 0x4E, 0xF, 0xF, false);
    else if (ctrl_sel == 2) t = __builtin_amdgcn_update_dpp(0, __builtin_bit_cast(int, v), 0x141, 0xF, 0xF, false);
    else t = __builtin_amdgcn_update_dpp(0, __builtin_bit_cast(int, v), 0x140, 0xF, 0xF, false);
    return v + __builtin_bit_cast(float, t);
}
__device__ __forceinline__ float row16_sum(float v) { v = dpp_add(v, 0); v = dpp_add(v, 1); v = dpp_add(v, 2); v = dpp_add(v, 3); return v; }
__device__ __forceinline__ float wave_sum(float v, int) {
    v = row16_sum(v);
    { auto r = __builtin_amdgcn_permlane16_swap(__float_as_uint(v), __float_as_uint(v), false, false); v = __uint_as_float(r[0]) + __uint_as_float(r[1]); }
    { auto r = __builtin_amdgcn_permlane32_swap(__float_as_uint(v), __float_as_uint(v), false, false); v = __uint_as_float(r[0]) + __uint_as_float(r[1]); }
    return v;
}
__device__ __forceinline__ float silu_f(float a) { return a * __builtin_amdgcn_rcpf(1.f + __builtin_amdgcn_exp2f(-LOG2E * a)); }
__device__ __forceinline__ float sigmoid_f(float a) { return __builtin_amdgcn_rcpf(1.f + __builtin_amdgcn_exp2f(-LOG2E * a)); }
__device__ __forceinline__ bf16x8 pack8(const f32x4 a, const f32x4 b) {
    u32x4 w; w.x = pk2(a[0], a[1]); w.y = pk2(a[2], a[3]); w.z = pk2(b[0], b[1]); w.w = pk2(b[2], b[3]); return __builtin_bit_cast(bf16x8, w);
}
__device__ __forceinline__ f32x4 mfma16(bf16x8 a, bf16x8 b, f32x4 c) { return __builtin_amdgcn_mfma_f32_16x16x32_bf16(a, b, c, 0, 0, 0); }
__device__ __forceinline__ int mod_index(int row) { return row < NPR ? 0 : 1 + ((row - NPR) >> 12); }
#define RLX_AGENT __ATOMIC_RELAXED, __HIP_MEMORY_SCOPE_AGENT
#define XB_TMO      128
#define XB_XCNT(j)  (256  + 64 * (j))
#define XB_XSUB(j)  (1280 + 64 * (j))
#define XB_XGEN(j)  (2304 + 64 * (j))
#define XB_TOP      3328
#define XB_TOPGEN   3392
#define XCD_BAR_WORDS 3456
#define XB_SPIN_CAP (1u << 18)

__device__ __forceinline__ unsigned xb_ld(unsigned* p)              { return __hip_atomic_load(p, __ATOMIC_RELAXED, __HIP_MEMORY_SCOPE_AGENT); }
__device__ __forceinline__ unsigned xb_add(unsigned* p, unsigned v) { return __hip_atomic_fetch_add(p, v, __ATOMIC_RELAXED, __HIP_MEMORY_SCOPE_AGENT); }
__device__ __forceinline__ unsigned xb_xcc_id() { return (unsigned)__builtin_amdgcn_readfirstlane((int)(__builtin_amdgcn_s_getreg((3 << 11) | 20) & 0xFu)); }
#define XB_SPIN(cond, bar) do { unsigned _sp = 0; while (cond) { __builtin_amdgcn_s_sleep(1); \
    if ((++_sp & 255u) == 0u) { if (xb_ld(&(bar)[XB_TMO])) break; if (_sp > XB_SPIN_CAP) { atomicAdd(&(bar)[XB_TMO], 1u); break; } } } } while (0)

struct XcdBarrier {
    unsigned* bar; unsigned x;
    volatile LAS unsigned* st;
};

__device__ __forceinline__ XcdBarrier xcd_barrier_post(unsigned* bar, volatile LAS unsigned* st, const bool leader) {
    XcdBarrier b; b.bar = bar; b.x = xb_xcc_id(); b.st = st;
    if (leader) (void)xb_add(&bar[XB_XCNT(b.x)], 1u);
    return b;
}
__device__ __forceinline__ void xcd_barrier_complete(unsigned* bar, unsigned x, unsigned& nloc, unsigned& nx) {
    const unsigned G = gridDim.x * gridDim.y * gridDim.z;
    unsigned sum, cnt, mine, sp = 0u;
    for (;;) {
        sum = 0u; cnt = 0u; mine = 0u;
#pragma unroll
        for (unsigned j = 0; j < 16; ++j) { const unsigned c = xb_ld(&bar[XB_XCNT(j)]); sum += c; cnt += (c > 0u) ? 1u : 0u; mine = (j == x) ? c : mine; }
        if (sum == G) break;
        __builtin_amdgcn_s_sleep(1);
        if ((++sp & 255u) == 0u) { if (xb_ld(&bar[XB_TMO])) break; if (sp > XB_SPIN_CAP) { atomicAdd(&bar[XB_TMO], 1u); break; } }
    }
    nloc = mine > 0u ? mine : 1u; nx = cnt > 0u ? cnt : 1u;
}

__device__ __forceinline__ void xcd_barrier(const XcdBarrier& b, const bool leader) {
    asm volatile("s_waitcnt vmcnt(0)" ::: "memory");
    __syncthreads();
    if (leader) {
        unsigned* bar = b.bar;
        __builtin_amdgcn_s_waitcnt(0);
        unsigned nloc = b.st[0], nx = b.st[1];
        if (nloc == 0u) { xcd_barrier_complete(bar, b.x, nloc, nx); b.st[0] = nloc; b.st[1] = nx; }
        const unsigned old = xb_add(&bar[XB_XSUB(b.x)], 1u);
        const unsigned gen = old / nloc;
        if (old + 1u == (gen + 1u) * nloc) {
            __builtin_amdgcn_fence(__ATOMIC_RELEASE, "agent");
            asm volatile("s_waitcnt vmcnt(0)" ::: "memory");
            const unsigned og = xb_add(&bar[XB_TOP], 1u);
            const unsigned tg = og / nx;
            if (og + 1u == (tg + 1u) * nx) xb_add(&bar[XB_TOPGEN], 1u);
            else XB_SPIN(xb_ld(&bar[XB_TOPGEN]) == tg, bar);
            __builtin_amdgcn_fence(__ATOMIC_ACQUIRE, "agent");
            xb_add(&bar[XB_XGEN(b.x)], 1u);
            asm volatile("s_waitcnt vmcnt(0)" ::: "memory");
        } else {
            XB_SPIN(xb_ld(&bar[XB_XGEN(b.x)]) == gen, bar);
            __builtin_amdgcn_fence(__ATOMIC_ACQUIRE, "agent");
            asm volatile("s_waitcnt vmcnt(0)" ::: "memory");
        }
    }
    __syncthreads();
}
namespace pg8 {
#define PG8_LAS __attribute__((address_space(3)))
typedef unsigned short bf16_t;
typedef short bf16x8 __attribute__((ext_vector_type(8)));
typedef float f32x4 __attribute__((ext_vector_type(4)));
typedef unsigned u32x4 __attribute__((ext_vector_type(4)));
constexpr int BM = 256, BK = 64, HALF = 128, HTB = HALF * BK * 2  , STAGE_BYTES = 8 * HTB, NXCD = 8, WGM = 8;

__host__ __device__ __forceinline__ int lds_byte(int r, int c) { const int st = (r >> 4) * 2 + (c >> 5), rr = r & 15, cc = c & 31, ob = rr * 64 + cc * 2; return st * 1024 + (ob ^ (((ob >> 9) & 1) << 5)); }
__host__ __device__ __forceinline__ void stage_rc(int b, int& R, int& C) { const int st = b / 1024, sb = b % 1024, swz = sb ^ (((sb >> 9) & 1) << 5); R = (st >> 1) * 16 + swz / 64; C = (st & 1) * 32 + (swz % 64) / 2; }
__host__ __device__ __forceinline__ int perm32(int rho) { const int n = rho >> 4, i = rho & 15; return 8 * (i >> 2) + 4 * n + (i & 3); }

struct Unit { int pm, pn, k0, nt, parts, tile; };
struct Gemm { const bf16_t* A; const bf16_t* Bt; int M, N, K; bool tiled; };

struct StaticOrder {
    int nM, nN, nwg, G, c, ntk;
    __host__ __device__ void init(int M, int N, int K, int G_, int c_) { nM = M / BM; nN = N / BM; nwg = nM * nN; G = G_; c = c_; ntk = K / BK; }
    __host__ __device__ bool next(int i, Unit& u) const {
        const long L = (long)i * G + c; if (L >= nwg) return false;
        int wgid = (int)L; { const int q = nwg / NXCD, r = nwg % NXCD, xcd = wgid % NXCD, off = wgid / NXCD; wgid = (xcd < r ? xcd * (q + 1) : r * (q + 1) + (xcd - r) * q) + off; }
        const int nig = WGM * nN, gid = wgid / nig, fm = gid * WGM, gsz = (nM - fm) < WGM ? (nM - fm) : WGM;
        u.pm = fm + ((wgid % nig) % gsz); u.pn = (wgid % nig) / gsz; u.k0 = 0; u.nt = ntk; u.parts = 1; u.tile = 0; return true;
    }
    __device__ __forceinline__ void a_ready(const Unit&) const {}
    __device__ __forceinline__ void done(const Unit&) const {}
};


struct TailSplit {
    StaticOrder so, all; int v;
    __host__ __device__ void init(int M, int N, int K, int G_, int b) { so.init(64 * BM, N, K, G_, b); all.init(M, N, K, G_, b); v = (G_ % 8 == 0) ? (b % 8) * (G_ / 8) + b / 8 : b; }
    __host__ __device__ bool split() const { return all.G == 256 && all.nwg == 320; }
    __host__ __device__ bool next(int i, Unit& u) const {
        if (!split()) return all.next(i, u);
        if (i == 0) return so.next(0, u);
        if (i > 1) return false;
        const int tidx = v >> 2, part = v & 3, q = so.ntk / 4, rem = so.ntk - 4 * q;
        int k0, nt;
        if ((q & 1) == 0) { nt = q + ((rem == 2 && part == 0) ? 2 : 0); k0 = part * q + ((rem == 2 && part > 0) ? 2 : 0); }
        else { const int a = q + 1, b2 = q - 1 + rem; nt = part < 2 ? a : b2; k0 = part < 2 ? part * a : 2 * a + (part - 2) * b2; }
        u.pm = 64 + (tidx >> 2); u.pn = tidx & 3; u.k0 = k0; u.nt = nt; u.parts = 4; u.tile = tidx * 4 + part; return true;
    }
    __device__ __forceinline__ void a_ready(const Unit&) const {}
    __device__ __forceinline__ void done(const Unit&) const {}
};
struct EpiBf16 {
    static constexpr bool PERM = true, AFTER_DRAIN = false;
    bf16_t* O; int ldc;
    __device__ __forceinline__ void operator()(const f32x4 (&acc)[2][2][4][2], const Unit& u, int wr, int wc, int fr, int fq) const {
        const int row0 = u.pm * BM + wr * 64 + fr; const int col0 = u.pn * BM + wc * 32 + 8 * fq;
#pragma unroll
        for (int ai = 0; ai < 2; ++ai)
#pragma unroll
            for (int m = 0; m < 4; ++m) { bf16_t* rowp = O + (size_t)(row0 + ai * HALF + m * 16) * ldc + col0;
#pragma unroll
                for (int bj = 0; bj < 2; ++bj) { const f32x4 v0 = acc[ai][bj][m][0], v1 = acc[ai][bj][m][1];
                    u32x4 w; w.x = ::pk2(v0[0], v0[1]); w.y = ::pk2(v0[2], v0[3]); w.z = ::pk2(v1[0], v1[1]); w.w = ::pk2(v1[2], v1[3]);
                    *(u32x4*)(rowp + bj * HALF) = w; } }
    }
};
struct EpiOddIn {
    static constexpr bool PERM = true, AFTER_DRAIN = false;
    bf16_t* O; unsigned char* ws; float* outp; const LAS float* rtl;
    __device__ __forceinline__ void operator()(const f32x4 (&acc)[2][2][4][2], const Unit& u, int wr, int wc, int fr, int fq) const {
        if (u.pn < 4) {
            const int row0 = u.pm * BM + wr * 64 + fr; const int col0 = u.pn * BM + wc * 32 + 8 * fq;
#pragma unroll
            for (int ai = 0; ai < 2; ++ai)
#pragma unroll
                for (int m = 0; m < 4; ++m) { bf16_t* rowp = O + (size_t)(row0 + ai * HALF + m * 16) * ::ODN + col0;
#pragma unroll
                    for (int bj = 0; bj < 2; ++bj) { const f32x4 v0 = acc[ai][bj][m][0], v1 = acc[ai][bj][m][1];
                        u32x4 w; w.x = ::pk2(v0[0], v0[1]); w.y = ::pk2(v0[2], v0[3]); w.z = ::pk2(v1[0], v1[1]); w.w = ::pk2(v1[2], v1[3]);
                        *(u32x4*)(rowp + bj * HALF) = w; } }
            return;
        }
        const bool isk = (u.pn == 4), lat = u.pm >= 16;
        const int b = lat ? (u.pm - 16) >> 4 : u.pm, tbase = lat ? ((u.pm - 16) & 15) * 256 : 0;
        bf16_t* dstb = lat ? (bf16_t*)(ws + (isk ? ::WS_KL : ::WS_VL)) + ((size_t)b * 4608 + 512 + tbase) * 256 : (bf16_t*)(ws + (isk ? ::WS_KP : ::WS_VP)) + (size_t)b * 256 * 256;
        float* fo = outp + (isk ? ::OUT_CK : ::OUT_CV) + (size_t)u.pm * 256 * 256;
        const int c0k = 64 * wc + 8 * fq, c0v = 32 * wc + 8 * fq;
#pragma unroll
        for (int ai = 0; ai < 2; ++ai)
#pragma unroll
            for (int m = 0; m < 4; ++m) {
                const int rowloc = ai * HALF + wr * 64 + m * 16 + fr, t = tbase + rowloc;
                f32x4 y[2][2];
#pragma unroll
                for (int bj = 0; bj < 2; ++bj)
#pragma unroll
                    for (int n = 0; n < 2; ++n) y[bj][n] = acc[ai][bj][m][n];
                if (isk) {
                    float ss = 0.f;
#pragma unroll
                    for (int bj = 0; bj < 2; ++bj)
#pragma unroll
                        for (int n = 0; n < 2; ++n) ss += (y[bj][n][0] * y[bj][n][0] + y[bj][n][1] * y[bj][n][1]) + (y[bj][n][2] * y[bj][n][2] + y[bj][n][3] * y[bj][n][3]);
                    { auto r = __builtin_amdgcn_permlane16_swap(__float_as_uint(ss), __float_as_uint(ss), false, false); ss = __uint_as_float(r[0]) + __uint_as_float(r[1]); }
                    { auto r = __builtin_amdgcn_permlane32_swap(__float_as_uint(ss), __float_as_uint(ss), false, false); ss = __uint_as_float(r[0]) + __uint_as_float(r[1]); }
                    const float rs = 1.0f / sqrtf(ss * (1.f / 64.f) + ::EPS);
#pragma unroll
                    for (int bj = 0; bj < 2; ++bj)
#pragma unroll
                        for (int n = 0; n < 2; ++n) y[bj][n] = y[bj][n] * rs * *(const LAS f32x4*)(rtl + 2048 + 32 * bj + 8 * fq + 4 * n);
                    if (lat) {
#pragma unroll
                        for (int bj = 0; bj < 2; ++bj) { const int posr = bj ? (t & 63) : (t >> 6);
#pragma unroll
                            for (int n = 0; n < 2; ++n) { const LAS f32x4* c4 = (const LAS f32x4*)(rtl + (posr * 16 + 8 * (fq & 1) + 4 * n) * 2);
                                const f32x4 cs0 = c4[0], cs1 = c4[1];
                                const float cc[4] = {cs0.x, cs0.z, cs1.x, cs1.z}, sn[4] = {cs0.y, cs0.w, cs1.y, cs1.w};
#pragma unroll
                                for (int e = 0; e < 4; ++e) { const float yv = y[bj][n][e];
                                    auto r = __builtin_amdgcn_permlane32_swap(__float_as_uint(yv), __float_as_uint(yv), false, false);
                                    const float o = (fq & 2) ? __uint_as_float(r[0]) : __uint_as_float(r[1]);
                                    y[bj][n][e] = (fq & 2) ? yv * cc[e] + o * sn[e] : yv * cc[e] - o * sn[e]; } } }
                    }
                }
#pragma unroll
                for (int bj = 0; bj < 2; ++bj) { const int col = isk ? c0k + 32 * bj : c0v + 128 * bj;
                    u32x4 w; w.x = ::pk2(y[bj][0][0], y[bj][0][1]); w.y = ::pk2(y[bj][0][2], y[bj][0][3]); w.z = ::pk2(y[bj][1][0], y[bj][1][1]); w.w = ::pk2(y[bj][1][2], y[bj][1][3]);
                    *(u32x4*)(dstb + (size_t)rowloc * 256 + col) = w;
                    if (!lat) { float* od = fo + (size_t)rowloc * 256 + col; *(f32x4*)od = y[bj][0]; *(f32x4*)(od + 4) = y[bj][1]; } }
            }
    }
};
struct EpiSwiGLU {
    static constexpr bool PERM = true, AFTER_DRAIN = false;
    bf16_t* O; int ldc;
    static __device__ __forceinline__ unsigned sg2(float a0, float a1, float b0, float b1) {
        const f32x2 av = {a0, a1}, bv = {b0, b1};
        const f32x2 den = (f32x2){__builtin_amdgcn_exp2f(a0), __builtin_amdgcn_exp2f(a1)} + 1.f;
        const f32x2 o = av * bv * (f32x2){__builtin_amdgcn_rcpf(den.x), __builtin_amdgcn_rcpf(den.y)};
        return ::pk2(o.x, o.y); }
    __device__ __forceinline__ void operator()(const f32x4 (&acc)[2][2][4][2], const Unit& u, int wr, int wc, int fr, int fq) const {
        const int col0 = u.pn * HALF + wc * 32 + 8 * fq;
        bf16_t* base = O + ((size_t)u.pm * (ldc / 64) + (col0 >> 6)) * (BM * 64) + (col0 & 63);
#pragma unroll
        for (int ai = 0; ai < 2; ++ai)
#pragma unroll
            for (int m = 0; m < 4; ++m) { bf16_t* rowp = base + (size_t)(wr * 64 + fr + ai * HALF + m * 16) * 64;
                const f32x4 a0 = acc[ai][0][m][0], a1 = acc[ai][0][m][1], b0 = acc[ai][1][m][0], b1 = acc[ai][1][m][1];
                u32x4 w; w.x = sg2(a0[0], a0[1], b0[0], b0[1]); w.y = sg2(a0[2], a0[3], b0[2], b0[3]); w.z = sg2(a1[0], a1[1], b1[0], b1[1]); w.w = sg2(a1[2], a1[3], b1[2], b1[3]);
                *(u32x4*)rowp = w; }
    }
};
struct EpiResid {
    static constexpr bool PERM = false, AFTER_DRAIN = false;
    const float* baseP; const float* baseS; float* out; const float* modl; bf16_t* slab; int gidx; float s;
    __device__ __forceinline__ void operator()(const f32x4 (&acc)[2][2][4][2], const Unit& u, int wr, int wc, int fr, int fq) const {
        if (u.parts > 1) {
            bf16_t* sl = slab + (size_t)u.tile * 65536;
#pragma unroll
            for (int ai = 0; ai < 2; ++ai)
#pragma unroll
                for (int m = 0; m < 4; ++m) { bf16_t* rp = sl + (ai * HALF + wr * 64 + m * 16 + fr) * 256 + wc * 32 + 4 * fq;
#pragma unroll
                    for (int bj = 0; bj < 2; ++bj)
#pragma unroll
                        for (int n = 0; n < 2; ++n) { const f32x4 a = acc[ai][bj][m][n]; *(u32x2*)(rp + bj * HALF + n * 16) = (u32x2){::pk2(a[0], a[1]), ::pk2(a[2], a[3])}; } }
            return;
        }
        const int mi = u.pm < 16 ? 0 : 1 + ((u.pm - 16) >> 4);
        const float* gate = modl + (size_t)(mi * 9 + gidx) * 1024;
        const float* base = u.pm < 16 ? baseP + (size_t)u.pm * BM * 1024 : baseS + (size_t)(u.pm - 16) * BM * 1024;
        float* o = out + (size_t)u.pm * BM * 1024;
        const int col0 = u.pn * BM + wc * 32 + 4 * fq;
        constexpr int DEPTH = 4;
        f32x4 gv[4];
#pragma unroll
        for (int q = 0; q < 4; ++q) gv[q] = *(const f32x4*)(gate + col0 + (q >> 1) * HALF + (q & 1) * 16);
        const size_t off0 = (size_t)(wr * 64 + fr) * 1024 + col0;
        f32x4 bs[DEPTH][4];
#define RESID_LD(it) _Pragma("unroll") for (int q = 0; q < 4; ++q) bs[(it) % DEPTH][q] = *(const f32x4*)(base + off0 + (size_t)(((it) >> 2) * HALF + ((it) & 3) * 16) * 1024 + (q >> 1) * HALF + (q & 1) * 16)
#pragma unroll
        for (int it = 0; it < DEPTH; ++it) { RESID_LD(it); }
        asm volatile("" : "+v"(gv[0]), "+v"(gv[1]), "+v"(gv[2]), "+v"(gv[3]) :: "memory");
#pragma unroll
        for (int q = 0; q < 4; ++q) gv[q] = gv[q] * s;
#pragma unroll
        for (int it = 0; it < 8; ++it) {
#pragma unroll
            for (int q = 0; q < 4; ++q) *(f32x4*)(o + off0 + (size_t)((it >> 2) * HALF + (it & 3) * 16) * 1024 + (q >> 1) * HALF + (q & 1) * 16) = bs[it % DEPTH][q] + gv[q] * acc[it >> 2][q >> 1][it & 3][q & 1];
            asm volatile("" ::: "memory");
            if (it + DEPTH < 8) { RESID_LD(it + DEPTH); asm volatile("" ::: "memory"); }
        }
#undef RESID_LD
    }
};
template <class Epi, class Sched, bool ALIGN_EPI = false, bool SP2 = false>
__device__ __forceinline__ void gemm_phase(PG8_LAS unsigned char* lds, const Gemm g, const Sched& S, const Epi& E, const int wid_in) {
    const int wid = wid_in, lane = ::fresh_lane(), tid = wid * 64 + lane, wr = wid >> 2, wc = wid & 3, fr = lane & 15, fq = lane >> 4;
    const int K = g.K;
    unsigned voffA[2], voffB[2];
#pragma unroll
    for (int i = 0; i < 2; ++i) { int R, C; stage_rc(tid * 16 + i * 8192, R, C); const int Rb = Epi::PERM ? ((R & ~31) + perm32(R & 31)) : R;
        const int ld = g.tiled ? BK : K;
        voffA[i] = (unsigned)(R * ld + C) * 2u; voffB[i] = (unsigned)(Rb * ld + C) * 2u; }
    const size_t kstep = g.tiled ? (size_t)(BM * BK * 2) : (size_t)(BK * 2);
    const size_t hstep = g.tiled ? (size_t)(HALF * BK * 2) : (size_t)HALF * K * 2;
    const size_t tstep = (size_t)BM * K * 2;
    const unsigned ldsw = (unsigned)wid * 1024u;
    const int aoff = lds_byte(wr * 64 + fr, fq * 8), boff = lds_byte(wc * 32 + fr, fq * 8);
#define PG8_SA(b, h) (((b) * 2 + (h)) * HTB)
#define PG8_SB(b, h) ((4 + (b) * 2 + (h)) * HTB)
#define PG8_STAGE(bufoff, gbase, voff) do { _Pragma("unroll") for (int _i = 0; _i < 2; ++_i) \
        __builtin_amdgcn_global_load_lds((const unsigned*)((const char*)(gbase) + (voff)[_i]), (PG8_LAS unsigned*)(lds + (bufoff) + ldsw + _i * 8192), 16, 0, 0); } while (0)
#define PG8_LDA(dst, b, h) do { _Pragma("unroll") for (int m = 0; m < 4; ++m) _Pragma("unroll") for (int k = 0; k < 2; ++k) dst[m][k] = *(const PG8_LAS bf16x8*)(lds + PG8_SA(b, h) + aoff + m * 2048 + k * 1024); } while (0)
#define PG8_LDB(dst, b, h) do { _Pragma("unroll") for (int n = 0; n < 2; ++n) _Pragma("unroll") for (int k = 0; k < 2; ++k) dst[n][k] = *(const PG8_LAS bf16x8*)(lds + PG8_SB(b, h) + boff + n * 2048 + k * 1024); } while (0)
#define PG8_MMA(ai, bj, At, Bt) do { __builtin_amdgcn_s_setprio(1); _Pragma("unroll") for (int m = 0; m < 4; ++m) _Pragma("unroll") for (int n = 0; n < 2; ++n) _Pragma("unroll") for (int k = 0; k < 2; ++k) \
        acc[ai][bj][m][n] = __builtin_amdgcn_mfma_f32_16x16x32_bf16(Bt[n][k], At[m][k], acc[ai][bj][m][n], 0, 0, 0); __builtin_amdgcn_s_setprio(0); } while (0)
#define PG8_WAIT_V(n) asm volatile("s_waitcnt vmcnt(" #n ")" ::: "memory")
#define PG8_WAIT_L(n) asm volatile("s_waitcnt lgkmcnt(" #n ")" ::: "memory")
#define PG8_BAR __builtin_amdgcn_s_barrier()
#define PG8_SCHED __builtin_amdgcn_sched_barrier(0)
    Unit cur, nxt; int ui = 0;
    if (!S.next(0, cur)) return;
    f32x4 acc[2][2][4][2];
#pragma unroll
    for (int a = 0; a < 2; ++a)
#pragma unroll
        for (int b = 0; b < 2; ++b)
#pragma unroll
            for (int m = 0; m < 4; ++m)
#pragma unroll
                for (int n = 0; n < 2; ++n) acc[a][b][m][n] = (f32x4){0.f, 0.f, 0.f, 0.f};
    bf16x8 At[4][2], B0[2][2], B1[2][2];
    const char* cA = (const char*)g.A + (size_t)cur.pm * tstep + (size_t)cur.k0 * kstep; const char* cB = (const char*)g.Bt + (size_t)cur.pn * tstep + (size_t)cur.k0 * kstep;
    S.a_ready(cur);
    if constexpr (SP2) {
        PG8_STAGE(PG8_SB(0, 0), cB, voffB); PG8_STAGE(PG8_SB(0, 1), cB + hstep, voffB); PG8_STAGE(PG8_SA(0, 0), cA, voffA); PG8_STAGE(PG8_SA(0, 1), cA + hstep, voffA);
        if (wr == 1) PG8_BAR;
        PG8_WAIT_V(2); PG8_BAR;
        PG8_STAGE(PG8_SB(1, 0), cB + kstep, voffB); PG8_STAGE(PG8_SA(1, 0), cA + kstep, voffA); PG8_STAGE(PG8_SB(1, 1), cB + hstep + kstep, voffB);
        PG8_WAIT_V(6); PG8_BAR;
    } else {
        PG8_STAGE(PG8_SB(0, 0), cB, voffB); PG8_STAGE(PG8_SA(0, 0), cA, voffA); PG8_STAGE(PG8_SB(0, 1), cB + hstep, voffB); PG8_STAGE(PG8_SA(0, 1), cA + hstep, voffA);
        if (wr == 1) PG8_BAR;
        PG8_WAIT_V(4); PG8_BAR;
        PG8_STAGE(PG8_SB(1, 0), cB + kstep, voffB); PG8_STAGE(PG8_SA(1, 0), cA + kstep, voffA); PG8_STAGE(PG8_SB(1, 1), cB + hstep + kstep, voffB);
        PG8_WAIT_V(6); PG8_BAR;
    }
    for (;;) {
        const bool has_next = S.next(ui + 1, nxt);
        const char* nA = has_next ? (const char*)g.A + (size_t)nxt.pm * tstep + (size_t)nxt.k0 * kstep : cA; const char* nB = has_next ? (const char*)g.Bt + (size_t)nxt.pn * tstep + (size_t)nxt.k0 * kstep : cB;
        const int nt = cur.nt;
        for (int t = 0; t < nt; t += 2) {
            const bool last = (t == nt - 2);
            const char* a1 = cA + (size_t)(t + 1) * kstep;
            const char* a2 = last ? nA : cA + (size_t)(t + 2) * kstep; const char* b2 = last ? nB : cB + (size_t)(t + 2) * kstep;
            const char* a3 = a2 + kstep; const char* b3 = b2 + kstep;
            if (last && has_next) S.a_ready(nxt);
            if constexpr (SP2) {
            PG8_LDB(B0, 0, 0); PG8_LDB(B1, 0, 1); PG8_SCHED; PG8_LDA(At, 0, 0); PG8_STAGE(PG8_SA(1, 1), a1 + hstep, voffA);
            PG8_WAIT_V(8); PG8_WAIT_L(0); PG8_BAR; PG8_MMA(0, 0, At, B0); PG8_MMA(0, 1, At, B1); PG8_BAR; PG8_SCHED;
            PG8_LDA(At, 0, 1); PG8_STAGE(PG8_SB(0, 0), b2, voffB); PG8_STAGE(PG8_SB(0, 1), b2 + hstep, voffB); PG8_STAGE(PG8_SA(0, 0), a2, voffA);
            PG8_WAIT_V(8); PG8_WAIT_L(0); PG8_BAR; PG8_MMA(1, 0, At, B0); PG8_MMA(1, 1, At, B1); PG8_BAR; PG8_SCHED;
            PG8_LDB(B0, 1, 0); PG8_LDB(B1, 1, 1); PG8_SCHED; PG8_LDA(At, 1, 0); PG8_STAGE(PG8_SA(0, 1), a2 + hstep, voffA);
            PG8_WAIT_V(8); PG8_WAIT_L(0); PG8_BAR; PG8_MMA(0, 0, At, B0); PG8_MMA(0, 1, At, B1); PG8_BAR; PG8_SCHED;
            PG8_LDA(At, 1, 1); PG8_STAGE(PG8_SB(1, 0), b3, voffB); PG8_STAGE(PG8_SB(1, 1), b3 + hstep, voffB); PG8_STAGE(PG8_SA(1, 0), a3, voffA);
            PG8_WAIT_V(8); PG8_WAIT_L(0); PG8_BAR; PG8_MMA(1, 0, At, B0); PG8_MMA(1, 1, At, B1); PG8_BAR; PG8_SCHED;
            } else {
            PG8_LDB(B0, 0, 0); PG8_SCHED; PG8_LDA(At, 0, 0); PG8_STAGE(PG8_SA(1, 1), a1 + hstep, voffA);
            PG8_WAIT_L(8); PG8_BAR; PG8_WAIT_L(0); PG8_MMA(0, 0, At, B0); PG8_BAR; PG8_SCHED;
            PG8_LDB(B1, 0, 1); PG8_STAGE(PG8_SB(0, 0), b2, voffB);
            PG8_BAR; PG8_WAIT_L(0); PG8_MMA(0, 1, At, B1); PG8_BAR;
            PG8_LDA(At, 0, 1); PG8_STAGE(PG8_SA(0, 0), a2, voffA);
            PG8_BAR; PG8_WAIT_L(0); PG8_MMA(1, 0, At, B0); PG8_BAR; PG8_SCHED;
            PG8_STAGE(PG8_SB(0, 1), b2 + hstep, voffB);
            PG8_WAIT_V(6); PG8_BAR; PG8_MMA(1, 1, At, B1); PG8_BAR;
            PG8_LDB(B0, 1, 0); PG8_SCHED; PG8_LDA(At, 1, 0); PG8_STAGE(PG8_SA(0, 1), a2 + hstep, voffA);
            PG8_WAIT_L(8); PG8_BAR; PG8_WAIT_L(0); PG8_MMA(0, 0, At, B0); PG8_BAR; PG8_SCHED;
            PG8_LDB(B1, 1, 1); PG8_STAGE(PG8_SB(1, 0), b3, voffB);
            PG8_BAR; PG8_WAIT_L(0); PG8_MMA(0, 1, At, B1); PG8_BAR;
            PG8_LDA(At, 1, 1); PG8_STAGE(PG8_SA(1, 0), a3, voffA);
            PG8_BAR; PG8_WAIT_L(0); PG8_MMA(1, 0, At, B0); PG8_BAR; PG8_SCHED;
            PG8_STAGE(PG8_SB(1, 1), b3 + hstep, voffB);
            PG8_WAIT_V(6); PG8_BAR; PG8_MMA(1, 1, At, B1); PG8_BAR;
            }
        }
        if constexpr (ALIGN_EPI) { if (wr == 0) PG8_BAR; }
        if constexpr (!Epi::AFTER_DRAIN) { E(acc, cur, wr, wc, fr, fq); S.done(cur); }
        if (!has_next) break;
#pragma unroll
        for (int a = 0; a < 2; ++a)
#pragma unroll
            for (int b = 0; b < 2; ++b)
#pragma unroll
                for (int m = 0; m < 4; ++m)
#pragma unroll
                    for (int n = 0; n < 2; ++n) acc[a][b][m][n] = (f32x4){0.f, 0.f, 0.f, 0.f};
        cur = nxt; cA = nA; cB = nB; ++ui;
        if constexpr (ALIGN_EPI) { if (wr == 1) PG8_BAR; }
    }
    PG8_WAIT_V(0);
    if constexpr (!ALIGN_EPI) { if (wr == 0) PG8_BAR; }
    PG8_BAR;
    if constexpr (Epi::AFTER_DRAIN) { E.fused(acc, cur, wr, wc, fr, fq, lds, wid, lane); S.done(cur); }
#undef PG8_SA
#undef PG8_SB
#undef PG8_STAGE
#undef PG8_LDA
#undef PG8_LDB
#undef PG8_MMA
#undef PG8_WAIT_V
#undef PG8_WAIT_L
#undef PG8_BAR
#undef PG8_SCHED
}
}
namespace attn_body {
using bf16=__hip_bfloat16;
using bf16x8=__attribute__((ext_vector_type(8)))short;
using s16x4=__attribute__((ext_vector_type(4)))short;
using f32x16=__attribute__((ext_vector_type(16)))float;
using u32x4=__attribute__((ext_vector_type(4)))unsigned;
constexpr int D=64,QP=1024,KVP=256,QSP=1536;
constexpr int NW=8,QBLK=32,QB=QBLK*NW,KVBLK=64;
constexpr int ATTN_UNIT_ROWS=QB;
__device__ __forceinline__ int crow(int r,int hi){return (r&3)+8*(r>>2)+4*hi;}
#define SBAR() __builtin_amdgcn_sched_barrier(0)
constexpr int NSLOT=3, SLOTB=8192;
constexpr int LDS_K=0, LDS_V=NSLOT*SLOTB, LDS_WS=2*NSLOT*SLOTB, LDS_OST=LDS_WS+NW*64*4, LDS_BYTES=LDS_OST+NW*4096;
constexpr float C2=0.125f*1.4426950408889634f;
__device__ __forceinline__ void glds16(const void*gsrc,unsigned lds_dst){unsigned keep;
  asm volatile("s_mov_b32 %0, m0\n\ts_mov_b32 m0, %2\n\ts_nop 0\n\tglobal_load_lds_dwordx4 %1, off\n\ts_mov_b32 m0, %0":"=&s"(keep):"v"(gsrc),"s"(lds_dst):"memory");}
__device__ __forceinline__ float max3f(float a,float b,float c){float r;asm("v_max3_f32 %0, %1, %2, %3":"=v"(r):"v"(a),"v"(b),"v"(c));return r;}
__device__ __forceinline__ float max2f(float a,float b){float r;asm("v_max_f32_e32 %0, %1, %2":"=v"(r):"v"(a),"v"(b));return r;}
__device__ __forceinline__ float fadd_s(float a,float b){float r;asm("v_add_f32_e32 %0, %1, %2":"=v"(r):"v"(a),"v"(b));return r;}
__device__ __forceinline__ float fsub_s(float a,float b){float r;asm("v_sub_f32_e32 %0, %1, %2":"=v"(r):"v"(a),"v"(b));return r;}
typedef float f32x2_t __attribute__((ext_vector_type(2))); typedef __bf16 bf16x2_t __attribute__((ext_vector_type(2)));
__device__ __forceinline__ unsigned cvtpk_s(float lo,float hi){f32x2_t v={lo,hi};bf16x2_t b=__builtin_convertvector(v,bf16x2_t);return __builtin_bit_cast(unsigned,b);}
#define WAIT_BAR(N) asm volatile("s_waitcnt vmcnt(" #N ") lgkmcnt(0)\n\ts_barrier":::"memory")

__device__ __forceinline__ void qkt(f32x16&p0,f32x16&p1,const char*Kslot,const bf16x8*qr,const f32x16&negm,int r32,int hi){
  const char*kb=Kslot+hi*1024+r32*16;
  #pragma unroll
  for(int d0=0;d0<4;++d0){
    const bf16x8 b0=*reinterpret_cast<const bf16x8*>(kb+d0*2048);
    const bf16x8 b1=*reinterpret_cast<const bf16x8*>(kb+d0*2048+512);
    if(d0==0){p0=__builtin_amdgcn_mfma_f32_32x32x16_bf16(b0,qr[0],negm,0,0,0);p1=__builtin_amdgcn_mfma_f32_32x32x16_bf16(b1,qr[0],negm,0,0,0);}
    else{p0=__builtin_amdgcn_mfma_f32_32x32x16_bf16(b0,qr[d0],p0,0,0,0);p1=__builtin_amdgcn_mfma_f32_32x32x16_bf16(b1,qr[d0],p1,0,0,0);}}
}
typedef __attribute__((address_space(3))) const char* lds_cptr;
typedef short v4i16_t __attribute__((ext_vector_type(4)));
__device__ __forceinline__ void kload8(bf16x8*kf,lds_cptr kp){
  kf[0]=*(const __attribute__((address_space(3))) bf16x8*)(kp);      kf[1]=*(const __attribute__((address_space(3))) bf16x8*)(kp+512);
  kf[2]=*(const __attribute__((address_space(3))) bf16x8*)(kp+2048); kf[3]=*(const __attribute__((address_space(3))) bf16x8*)(kp+2560);
  kf[4]=*(const __attribute__((address_space(3))) bf16x8*)(kp+4096); kf[5]=*(const __attribute__((address_space(3))) bf16x8*)(kp+4608);
  kf[6]=*(const __attribute__((address_space(3))) bf16x8*)(kp+6144); kf[7]=*(const __attribute__((address_space(3))) bf16x8*)(kp+6656);
}
__device__ __forceinline__ void kload2(bf16x8*kf,lds_cptr kp,int j){ kf[2*j]=*(const __attribute__((address_space(3))) bf16x8*)(kp+j*2048); kf[2*j+1]=*(const __attribute__((address_space(3))) bf16x8*)(kp+j*2048+512); }
__device__ __forceinline__ s16x4 vtr(lds_cptr p){ return __builtin_bit_cast(s16x4,__builtin_amdgcn_ds_read_tr16_b64_v4i16((__attribute__((address_space(3))) v4i16_t*)p)); }
__device__ __forceinline__ float rowmax(const f32x16&p0,const f32x16&p1){
  float a=max3f(p0[0],p0[1],p1[0]),b=max3f(p0[2],p0[3],p1[1]);a=max3f(a,p1[2],p1[3]);
  #pragma unroll
  for(int r=4;r<16;r+=4){a=max3f(a,p0[r],p0[r+1]);b=max3f(b,p0[r+2],p0[r+3]);a=max3f(a,p1[r],p1[r+1]);b=max3f(b,p1[r+2],p1[r+3]);}
  const float m=max2f(a,b);
  auto rr=__builtin_amdgcn_permlane32_swap(__float_as_uint(m),__float_as_uint(m),false,false);
  return max2f(__uint_as_float(rr[0]),__uint_as_float(rr[1]));
}
__device__ __forceinline__ void pv(f32x16*o,int vb,bf16x8 pa0,bf16x8 pa1,bf16x8 pa2,bf16x8 pa3){
  #pragma unroll
  for(int d0=0;d0<2;++d0){s16x4 lo[4],hi[4];
    #pragma unroll
    for(int ks=0;ks<4;++ks){
      asm volatile("ds_read_b64_tr_b16 %0,%1 offset:%c2":"=&v"(lo[ks]):"v"(vb),"i"(d0*4096+ks*1024):"memory");
      asm volatile("ds_read_b64_tr_b16 %0,%1 offset:%c2":"=&v"(hi[ks]):"v"(vb),"i"(d0*4096+ks*1024+512):"memory");}
    asm volatile("s_waitcnt lgkmcnt(0)":::"memory");SBAR();
    #define PK(k) (bf16x8){lo[k][0],lo[k][1],lo[k][2],lo[k][3],hi[k][0],hi[k][1],hi[k][2],hi[k][3]}
    o[d0]=__builtin_amdgcn_mfma_f32_32x32x16_bf16(pa0,PK(0),o[d0],0,0,0);
    o[d0]=__builtin_amdgcn_mfma_f32_32x32x16_bf16(pa1,PK(1),o[d0],0,0,0);
    o[d0]=__builtin_amdgcn_mfma_f32_32x32x16_bf16(pa2,PK(2),o[d0],0,0,0);
    o[d0]=__builtin_amdgcn_mfma_f32_32x32x16_bf16(pa3,PK(3),o[d0],0,0,0);
    #undef PK
  }
}

#ifndef ATTN_STORE16
#define ATTN_STORE16(p,v) (*(u32x4*)(p)=(v))
#endif
template<int THRL> __device__ __forceinline__ void attn_unit(const bf16*Q0,const bf16*__restrict__ Kh,const bf16*__restrict__ Vh,bf16*O0,const int NT,char*shm,const int wid,const float*qnw,const float*rope,const int tpos){
  const int lane=::fresh_lane(),tid=wid*64+lane,r32=lane&31,hi=lane>>5;
  const bf16*Qw=Q0+(long)(wid*QBLK)*QSP;
  const unsigned lds0=(unsigned)(uintptr_t)shm;
  float*wsf=(float*)(shm+LDS_WS)+wid*64;
  const bf16*ksrc=Kh+(long)lane*KVP+wid*8;
  const bf16*vsrc=Vh+(long)(16*(wid&3)+(lane>>2))*KVP+(wid>>2)*32+(lane&3)*8;
  const unsigned kdst=lds0+LDS_K+wid*1024, vdst=lds0+LDS_V+wid*1024;
  #define DMA_K(t,slot) glds16(ksrc+(long)(t)*KVBLK*KVP,(unsigned)__builtin_amdgcn_readfirstlane(kdst+(slot)))
  #define DMA_V(t,slot) glds16(vsrc+(long)(t)*KVBLK*KVP,(unsigned)__builtin_amdgcn_readfirstlane(vdst+(slot)))
  const int vb0=(int)(lds0+LDS_V)+((lane>>4)&1)*32+(lane&3)*8+(4*hi+((lane&15)>>2))*64;
  const char*Kbase=shm+LDS_K; bf16x8 kf[8];
  const lds_cptr shm3=(lds_cptr)shm; const lds_cptr kp0=shm3+LDS_K+hi*1024+r32*16; const lds_cptr vp0=shm3+LDS_V+((lane>>4)&1)*32+(lane&3)*8+(4*hi+((lane&15)>>2))*64;
  DMA_K(0,0);DMA_V(0,0);DMA_K(1,SLOTB);
  bf16x8 qr[4];
  { float x[4][8]; float ss=0.f;
    #pragma unroll
    for(int d0=0;d0<4;++d0){ const u32x4 raw=*reinterpret_cast<const u32x4*>(&Qw[(long)r32*QSP+d0*16+hi*8]);
      x[d0][0]=__uint_as_float(raw.x<<16);x[d0][1]=__uint_as_float(raw.x&0xffff0000u);x[d0][2]=__uint_as_float(raw.y<<16);x[d0][3]=__uint_as_float(raw.y&0xffff0000u);
      x[d0][4]=__uint_as_float(raw.z<<16);x[d0][5]=__uint_as_float(raw.z&0xffff0000u);x[d0][6]=__uint_as_float(raw.w<<16);x[d0][7]=__uint_as_float(raw.w&0xffff0000u);
      #pragma unroll
      for(int e=0;e<8;++e)ss+=x[d0][e]*x[d0][e]; }
    { auto rr=__builtin_amdgcn_permlane32_swap(__float_as_uint(ss),__float_as_uint(ss),false,false); ss=__uint_as_float(rr[0])+__uint_as_float(rr[1]); }
    const float rs=C2/sqrtf(ss*(1.f/64.f)+1e-6f);
    #pragma unroll
    for(int d0=0;d0<4;++d0){ const float*wq=qnw+d0*16+hi*8;
      #pragma unroll
      for(int e=0;e<8;++e)x[d0][e]*=rs*wq[e]; }
    if(tpos>=0){ const int t=tpos+wid*QBLK+r32; const float*cr=rope+(size_t)((t>>6)*16+8*hi)*2,*cc=rope+(size_t)((t&63)*16+8*hi)*2;
      #pragma unroll
      for(int e=0;e<8;++e){ const float c1=cr[2*e],s1=cr[2*e+1],c2=cc[2*e],s2=cc[2*e+1];
        const float a0=x[0][e],a1=x[1][e],b0=x[2][e],b1=x[3][e];
        x[0][e]=a0*c1-a1*s1; x[1][e]=a1*c1+a0*s1; x[2][e]=b0*c2-b1*s2; x[3][e]=b1*c2+b0*s2; } }
    #pragma unroll
    for(int d0=0;d0<4;++d0){ u32x4 w; w.x=cvtpk_s(x[d0][0],x[d0][1]); w.y=cvtpk_s(x[d0][2],x[d0][3]); w.z=cvtpk_s(x[d0][4],x[d0][5]); w.w=cvtpk_s(x[d0][6],x[d0][7]); qr[d0]=__builtin_bit_cast(bf16x8,w); } }
  float mhat=0.f,l_reg=0.f;f32x16 o[2],negm;{float z_;asm volatile("v_mov_b32 %0, 0":"=v"(z_)); _Pragma("unroll") for(int r=0;r<16;++r){o[0][r]=z_;o[1][r]=z_;negm[r]=z_;}} asm volatile("":"+v"(negm));
  #define CMASK(P0,P1,t) do{}while(0)
  bool resc=false;
  #define START(P0,P1) do{ const float rm=rowmax(P0,P1); resc=false; \
    { const float dl=rm; mhat=fadd_s(mhat,dl); \
      _Pragma("unroll") for(int r=0;r<16;++r){P0[r]=fsub_s(P0[r],dl);P1[r]=fsub_s(P1[r],dl);} \
      _Pragma("unroll") for(int r=0;r<16;++r)negm[r]=-mhat; asm volatile("":"+v"(negm)); } \
    _Pragma("unroll") for(int r=0;r<16;++r)P0[r]=__builtin_amdgcn_exp2f(P0[r]); }while(0)
  #define RESC() do{ if(resc){ asm volatile("s_waitcnt lgkmcnt(0)":::"memory"); \
      _Pragma("unroll") for(int d_=0;d_<2;++d_) _Pragma("unroll") for(int r=0;r<16;++r)o[d_][r]*=wsf[crow(r,hi)]; } }while(0)
  f32x16 pA0,pA1,pB0,pB1;
  int sl_prev=0,sl_cur=0,sl_next=SLOTB;
  #define ROT() do{sl_prev=sl_cur;sl_cur=sl_next;sl_next=(sl_next==(NSLOT-1)*SLOTB)?0:sl_next+SLOTB;}while(0)
  DMA_K(2,2*SLOTB);
  WAIT_BAR(3);
  qkt(pA0,pA1,Kbase,qr,negm,r32,hi);asm volatile("s_nop 15\n\ts_nop 7":"+v"(pA0),"+v"(pA1));CMASK(pA0,pA1,0);
  START(pA0,pA1);
  _Pragma("unroll") for(int r=0;r<16;++r)pA1[r]=__builtin_amdgcn_exp2f(pA1[r]);
  WAIT_BAR(0);
  DMA_K(3,0);DMA_V(1,SLOTB);
  ROT();
  kload8(kf,kp0+sl_cur);
  WAIT_BAR(2);
  s16x4 vlo[8],vhi[8]; u32x4 pw0,pw1,pw2,pw3;
  #define PKW(P,B) cvtpk_s(P[B],P[B+1])
  #define PAF(k) __builtin_bit_cast(bf16x8,pw##k)
  #define VFR(i) (bf16x8){vlo[i][0],vlo[i][1],vlo[i][2],vlo[i][3],vhi[i][0],vhi[i][1],vhi[i][2],vhi[i][3]}
  #define PIN(x) asm volatile("":"+v"(x))
  #define MX3(a,b,c) __builtin_fmaxf(__builtin_fmaxf((a),(b)),(c))
  #define GAPA(MF,A0,A1,A2,A3,W0,W1,PW) do{ MF; sacc+=A0; sacc+=A1; sacc+=A2; sacc+=A3; PIN(sacc); W0; W1; PIN(PW); SBAR(); }while(0)
  #define EX(v) __builtin_amdgcn_exp2f(v)
  #define GAPB(MF,X,B) do{ MF; X[B]=EX(X[B]); X[B+1]=EX(X[B+1]); X[B+2]=EX(X[B+2]); X[B+3]=EX(X[B+3]); PIN(X); SBAR(); }while(0)
  #define VRD(i) do{ vlo[i]=vtr(vp_+(((i)>>2)*4096+((i)&3)*1024)); vhi[i]=vtr(vp_+(((i)>>2)*4096+((i)&3)*1024+512)); }while(0)
  #define KRD(G,j) do{ if(G){ kload2(kf,kp0+sl_next,j); SBAR(); } }while(0)
  #define STEP(C0,C1,P0,P1,t,GK,GV,GL) do{ SBAR(); \
    const lds_cptr vp_=vp0+sl_prev; \
    VRD(0); SBAR(); float sacc=(P0[0]+P0[1]); \
    GAPA(C0=__builtin_amdgcn_mfma_f32_32x32x16_bf16(kf[0],qr[0],negm,0,0,0), P0[2],P0[3],P0[4],P0[5],     pw0[0]=PKW(P0,0), pw0[1]=PKW(P0,2), pw0); \
    VRD(4); SBAR(); GAPA(C1=__builtin_amdgcn_mfma_f32_32x32x16_bf16(kf[1],qr[0],negm,0,0,0), P0[6],P0[7],P0[8],P0[9],     pw0[2]=PKW(P0,4), pw0[3]=PKW(P0,6), pw0); \
    VRD(1); SBAR(); GAPA(C0=__builtin_amdgcn_mfma_f32_32x32x16_bf16(kf[2],qr[1],C0,0,0,0),   P0[10],P0[11],P0[12],P0[13], pw1[0]=PKW(P0,8), pw1[1]=PKW(P0,10), pw1); \
    VRD(5); SBAR(); GAPA(C1=__builtin_amdgcn_mfma_f32_32x32x16_bf16(kf[3],qr[1],C1,0,0,0),   P0[14],P0[15],P1[0],P1[1],   pw1[2]=PKW(P0,12),pw1[3]=PKW(P0,14), pw1); \
    VRD(2); SBAR(); GAPA(C0=__builtin_amdgcn_mfma_f32_32x32x16_bf16(kf[4],qr[2],C0,0,0,0),   P1[2],P1[3],P1[4],P1[5],     pw2[0]=PKW(P1,0), pw2[1]=PKW(P1,2), pw2); \
    VRD(6); SBAR(); GAPA(C1=__builtin_amdgcn_mfma_f32_32x32x16_bf16(kf[5],qr[2],C1,0,0,0),   P1[6],P1[7],P1[8],P1[9],     pw2[2]=PKW(P1,4), pw2[3]=PKW(P1,6), pw2); \
    VRD(3); SBAR(); GAPA(C0=__builtin_amdgcn_mfma_f32_32x32x16_bf16(kf[6],qr[3],C0,0,0,0),   P1[10],P1[11],P1[12],P1[13], pw3[0]=PKW(P1,8), pw3[1]=PKW(P1,10), pw3); \
    VRD(7); SBAR(); GAPA(C1=__builtin_amdgcn_mfma_f32_32x32x16_bf16(kf[7],qr[3],C1,0,0,0),   P1[14],P1[15],0.f,0.f,       pw3[2]=PKW(P1,12),pw3[3]=PKW(P1,14), pw3); \
    l_reg+=sacc; \
    if(GK){DMA_K((t)+3,sl_cur);} if(GV){DMA_V((t)+1,sl_next);} \
    CMASK(C0,C1,t); \
    { float a=MX3(C0[0],C0[1],C1[0]),b=MX3(C0[2],C0[3],C1[1]); a=MX3(a,C1[2],C1[3]); \
      _Pragma("unroll") for(int r=4;r<16;r+=4){a=MX3(a,C0[r],C0[r+1]);b=MX3(b,C0[r+2],C0[r+3]);a=MX3(a,C1[r],C1[r+1]);b=MX3(b,C1[r+2],C1[r+3]);} \
      float rm=__builtin_fmaxf(a,b); { auto rr=__builtin_amdgcn_permlane32_swap(__float_as_uint(rm),__float_as_uint(rm),false,false); rm=__builtin_fmaxf(__uint_as_float(rr[0]),__uint_as_float(rr[1])); } \
      resc=false; \
      if(__builtin_expect(__any(rm>(float)THRL),0)){ const float dl=__builtin_fmaxf(rm,0.f); mhat+=dl; \
        _Pragma("unroll") for(int r=0;r<16;++r){C0[r]-=dl;C1[r]-=dl;} \
        _Pragma("unroll") for(int r=0;r<16;++r)negm[r]=-mhat; asm volatile("":"+v"(negm)); \
        const float f=__builtin_amdgcn_exp2f(-dl); l_reg*=f; if(hi==0)wsf[r32]=f; resc=true; } } \
    SBAR(); \
    GAPB(o[0]=__builtin_amdgcn_mfma_f32_32x32x16_bf16(PAF(0),VFR(0),o[0],0,0,0), C0,0); \
    GAPB(o[1]=__builtin_amdgcn_mfma_f32_32x32x16_bf16(PAF(0),VFR(4),o[1],0,0,0), C0,4); \
    KRD(GL,0); GAPB(o[0]=__builtin_amdgcn_mfma_f32_32x32x16_bf16(PAF(1),VFR(1),o[0],0,0,0), C0,8); \
    KRD(GL,1); GAPB(o[1]=__builtin_amdgcn_mfma_f32_32x32x16_bf16(PAF(1),VFR(5),o[1],0,0,0), C0,12); \
    KRD(GL,2); GAPB(o[0]=__builtin_amdgcn_mfma_f32_32x32x16_bf16(PAF(2),VFR(2),o[0],0,0,0), C1,0); \
    KRD(GL,3); GAPB(o[1]=__builtin_amdgcn_mfma_f32_32x32x16_bf16(PAF(2),VFR(6),o[1],0,0,0), C1,4); \
    GAPB(o[0]=__builtin_amdgcn_mfma_f32_32x32x16_bf16(PAF(3),VFR(3),o[0],0,0,0), C1,8); \
    GAPB(o[1]=__builtin_amdgcn_mfma_f32_32x32x16_bf16(PAF(3),VFR(7),o[1],0,0,0), C1,12); \
    }while(0)
  int t=1;
  #undef CMASK
  #define CMASK(P0,P1,t) do{}while(0)
  for(;t+5<NT;t+=2){
    STEP(pB0,pB1,pA0,pA1,t,true,true,true);     WAIT_BAR(2); RESC(); ROT();
    STEP(pA0,pA1,pB0,pB1,t+1,true,true,true);   WAIT_BAR(2); RESC(); ROT();
  }
  #undef CMASK
  #define CMASK(P0,P1,t) do{}while(0)
  #define ENDW(tt) do{ if((tt)+3<NT){WAIT_BAR(2);} else if((tt)+2<NT){WAIT_BAR(1);} else {WAIT_BAR(0);} }while(0)
  for(;t+1<NT;t+=2){
    STEP(pB0,pB1,pA0,pA1,t,(t+3<NT),(t+1<NT),(t+1<NT));       ENDW(t);   RESC(); ROT();
    STEP(pA0,pA1,pB0,pB1,t+1,(t+4<NT),(t+2<NT),(t+2<NT));     ENDW(t+1); RESC(); ROT();
  }
  STEP(pB0,pB1,pA0,pA1,NT-1,false,false,false); RESC();
  { float sacc=pB0[0]+pB0[1]; _Pragma("unroll") for(int r=2;r<16;++r)sacc+=pB0[r]; _Pragma("unroll") for(int r=0;r<16;++r)sacc+=pB1[r]; l_reg+=sacc;
    pw0=(u32x4){PKW(pB0,0),PKW(pB0,2),PKW(pB0,4),PKW(pB0,6)};pw1=(u32x4){PKW(pB0,8),PKW(pB0,10),PKW(pB0,12),PKW(pB0,14)};pw2=(u32x4){PKW(pB1,0),PKW(pB1,2),PKW(pB1,4),PKW(pB1,6)};pw3=(u32x4){PKW(pB1,8),PKW(pB1,10),PKW(pB1,12),PKW(pB1,14)};
    SBAR(); pv(o,vb0+sl_cur,PAF(0),PAF(1),PAF(2),PAF(3)); }
  #undef PKW
  #undef PAF
  #undef VFR
  #undef PIN
  #undef MX3
  #undef GAPA
  #undef GAPB
  #undef EX
  #undef VRD
  #undef KRD
  #undef STEP
  #undef ENDW
  {auto rr=__builtin_amdgcn_permlane32_swap(__float_as_uint(l_reg),__float_as_uint(l_reg),false,false);l_reg=__uint_as_float(rr[0])+__uint_as_float(rr[1]);}
  if(hi==0)wsf[32+r32]=l_reg;asm volatile("s_waitcnt lgkmcnt(0)":::"memory");
  float rli[16];
  #pragma unroll
  for(int r=0;r<16;++r)rli[r]=__builtin_amdgcn_rcpf(wsf[32+crow(r,hi)]);
  bf16*Ow=O0+(long)(wid*QBLK)*QP;
  { bf16*stg=(bf16*)(shm+LDS_OST)+wid*2048;
    #pragma unroll
    for(int r=0;r<16;++r){const int orow=crow(r,hi);
      #pragma unroll
      for(int d0=0;d0<2;++d0)stg[orow*64+d0*32+r32]=__float2bfloat16(o[d0][r]*rli[r]);}
    asm volatile("s_waitcnt lgkmcnt(0)":::"memory");
    #pragma unroll
    for(int i=0;i<4;++i){const int row=i*8+(lane>>3),ch=lane&7; const u32x4 v=*(const u32x4*)(stg+row*64+ch*8); ATTN_STORE16(Ow+(long)row*QP+ch*8,v);} }
  asm volatile("s_waitcnt lgkmcnt(0)\n\ts_barrier":::"memory");
  #undef DMA_K
  #undef DMA_V
  #undef CMASK
  #undef START
  #undef RESC
  #undef ROT
}
constexpr int ATTN_LDS_BYTES=LDS_BYTES;
#undef SBAR
#undef WAIT_BAR
}
struct Frame { LAS unsigned char* lds; int tid, lane, wave, gw, ngw, bid, nb; };

__device__ __forceinline__ void tp_load(f32x4 (&v)[8], const float* W, int Nsrc, int scol0, int k0, int lane) {
    const float* p = W + (size_t)(k0 + (lane >> 3)) * Nsrc + scol0 + 4 * (lane & 7);
#pragma unroll
    for (int i = 0; i < 8; ++i) v[i] = *(const f32x4*)(p + (size_t)(8 * i) * Nsrc);
}
__device__ __forceinline__ void tp_store(const f32x4 (&v)[8], int K, bf16_t* WT, int drow0, int k0, LAS float* scr, int lane, const float sc = 1.f, const bool tiled = false) {
    { LAS float* d = scr + (lane >> 3) * 33 + 4 * (lane & 7);
#pragma unroll
      for (int i = 0; i < 8; ++i) { d[(8 * i) * 33 + 0] = v[i].x; d[(8 * i) * 33 + 1] = v[i].y; d[(8 * i) * 33 + 2] = v[i].z; d[(8 * i) * 33 + 3] = v[i].w; } }
    asm volatile("s_waitcnt lgkmcnt(0)" ::: "memory");
    const int c = lane & 7;
#pragma unroll
    for (int j = 0; j < 4; ++j) { const int n = (lane >> 3) + 8 * j; const LAS float* s = scr + (8 * c) * 33 + n;
        u32x4 o; o.x = pk2(s[0 * 33] * sc, s[1 * 33] * sc); o.y = pk2(s[2 * 33] * sc, s[3 * 33] * sc); o.z = pk2(s[4 * 33] * sc, s[5 * 33] * sc); o.w = pk2(s[6 * 33] * sc, s[7 * 33] * sc);
        const int rr = drow0 + n;
        bf16_t* dp = tiled ? WT + (((size_t)(rr >> 8) * (K >> 6) + (k0 >> 6)) * 256 + (rr & 255)) * 64 + 8 * c : WT + (size_t)rr * K + k0 + 8 * c;
        *(u32x4*)dp = o; }
    asm volatile("s_waitcnt lgkmcnt(0)" ::: "memory");
}
__device__ __forceinline__ void conv_plain(const Frame& F, const float* W, int K, int Nsrc, int Nd, bf16_t* WT, LAS float* scr, const bool tiled = false) {
    const int nblk = Nd / 32, nitems = (K / 64) * nblk;
    for (int it = F.gw; it < nitems; it += 2 * F.ngw) { const int it2 = it + F.ngw; const bool two = it2 < nitems;
        const int kb = it / nblk, nb = it % nblk, kb2 = it2 / nblk, nb2 = it2 % nblk;
        f32x4 va[8], vb[8];
        tp_load(va, W, Nsrc, 32 * nb, 64 * kb, F.lane); if (two) tp_load(vb, W, Nsrc, 32 * nb2, 64 * kb2, F.lane);
        tp_store(va, K, WT, 32 * nb, 64 * kb, scr, F.lane, 1.f, tiled); if (two) tp_store(vb, K, WT, 32 * nb2, 64 * kb2, scr, F.lane, 1.f, tiled); }
}
__device__ __forceinline__ int swiglu_scol(int n0) { const int pn = n0 >> 8, bj = (n0 >> 7) & 1, j = n0 & 127; return bj * FFH + 128 * pn + j; }
__device__ __forceinline__ void conv_swiglu(const Frame& F, const float* W, bf16_t* WT, LAS float* scr) {
    const int nblk = FF2 / 32, nitems = (DM / 64) * nblk;
    for (int it = F.gw; it < nitems; it += 2 * F.ngw) { const int it2 = it + F.ngw; const bool two = it2 < nitems;
        const int kb = it / nblk, n0 = 32 * (it % nblk), kb2 = it2 / nblk, n02 = 32 * (it2 % nblk);
        f32x4 va[8], vb[8];
        tp_load(va, W, FF2, swiglu_scol(n0), 64 * kb, F.lane); if (two) tp_load(vb, W, FF2, swiglu_scol(n02), 64 * kb2, F.lane);
        tp_store(va, DM, WT, n0, 64 * kb, scr, F.lane, ((n0 >> 7) & 1) ? -0.6931471805599453f : -LOG2E); if (two) tp_store(vb, DM, WT, n02, 64 * kb2, scr, F.lane, ((n02 >> 7) & 1) ? -0.6931471805599453f : -LOG2E); }
}
__device__ __forceinline__ void conv_l0_in(const Frame& F, const Params& P, int half, unsigned char* ws) {
    LAS float* scr = (LAS float*)(F.lds + F.wave * 16384);
    conv_swiglu(F, as_global(P.ffn_w_in) + (size_t)half * DM * FF2, (bf16_t*)(ws + (half ? WS_WFIN1 : WS_WFIN0)), scr);
}
__device__ __forceinline__ void conv_l0_out(const Frame& F, const Params& P, int half, unsigned char* ws) {
    LAS float* scr = (LAS float*)(F.lds + F.wave * 16384);
    conv_plain(F, as_global(P.ffn_w_out) + (size_t)half * FFH * DM, FFH, DM, DM, (bf16_t*)(ws + (half ? WS_WFOUT1 : WS_WFOUT0)), scr, true);
}
__device__ __forceinline__ void conv_l0_half(const Frame& F, const Params& P, int half, unsigned char* ws) { conv_l0_in(F, P, half, ws); conv_l0_out(F, P, half, ws); }
__device__ __forceinline__ void conv_even_in(const Frame& F, const Params& P, unsigned char* ws) {
    LAS float* scr = (LAS float*)(F.lds + F.wave * 16384);
    conv_plain(F, as_global(P.even_w_in), DM, EVFULL, EVN, (bf16_t*)(ws + WS_WMIN), scr);
}
__device__ __forceinline__ void conv_even_out(const Frame& F, const Params& P, unsigned char* ws) {
    LAS float* scr = (LAS float*)(F.lds + F.wave * 16384);
    conv_plain(F, as_global(P.even_w_out), DM, DM, DM, (bf16_t*)(ws + WS_WMOUT), scr);
}
__device__ __forceinline__ int odd_scol(int n0) { const int c = n0 - 1024; return (c < 0 || c >= 256) ? n0 : 1024 + 64 * ((c >> 5) & 3) + 32 * (c >> 7) + (c & 31); }
__device__ __forceinline__ void conv_l1_a2(const Frame& F, const Params& P, unsigned char* ws) {
    LAS float* scr = (LAS float*)(F.lds + F.wave * 16384);
    const float* W = as_global(P.odd_w_in); bf16_t* WT = (bf16_t*)(ws + WS_WMIN);
    const int nblk = ODN / 32, nitems = (DM / 64) * nblk;
    for (int it = F.gw; it < nitems; it += 2 * F.ngw) { const int it2 = it + F.ngw; const bool two = it2 < nitems;
        const int kb = it / nblk, n0 = 32 * (it % nblk), kb2 = it2 / nblk, n02 = 32 * (it2 % nblk);
        f32x4 va[8], vb[8];
        tp_load(va, W, ODN, odd_scol(n0), 64 * kb, F.lane); if (two) tp_load(vb, W, ODN, odd_scol(n02), 64 * kb2, F.lane);
        tp_store(va, DM, WT, n0, 64 * kb, scr, F.lane); if (two) tp_store(vb, DM, WT, n02, 64 * kb2, scr, F.lane); }
}

__device__ __forceinline__ void mod_wait(f32x2 (&d)[32], const int n) {
    if (n) asm volatile("s_waitcnt vmcnt(32)" : "+v"(d[0]), "+v"(d[1]), "+v"(d[2]), "+v"(d[3]), "+v"(d[4]), "+v"(d[5]), "+v"(d[6]), "+v"(d[7]), "+v"(d[8]), "+v"(d[9]), "+v"(d[10]), "+v"(d[11]), "+v"(d[12]), "+v"(d[13]), "+v"(d[14]), "+v"(d[15]) :: "memory"); else asm volatile("s_waitcnt vmcnt(0)" : "+v"(d[0]), "+v"(d[1]), "+v"(d[2]), "+v"(d[3]), "+v"(d[4]), "+v"(d[5]), "+v"(d[6]), "+v"(d[7]), "+v"(d[8]), "+v"(d[9]), "+v"(d[10]), "+v"(d[11]), "+v"(d[12]), "+v"(d[13]), "+v"(d[14]), "+v"(d[15]) :: "memory");
    asm volatile("" : "+v"(d[16]), "+v"(d[17]), "+v"(d[18]), "+v"(d[19]), "+v"(d[20]), "+v"(d[21]), "+v"(d[22]), "+v"(d[23]), "+v"(d[24]), "+v"(d[25]), "+v"(d[26]), "+v"(d[27]), "+v"(d[28]), "+v"(d[29]), "+v"(d[30]), "+v"(d[31]));
}
template <bool DBL>
__device__ __forceinline__ void phase_mod(const Frame& F, const Params& P, unsigned char* ws, int ulo, int uhi, int vbid, int vnb) {
    LAS float* sc = (LAS float*)F.lds;
    LAS float* red = sc + 5 * 1024;
    for (int i = F.tid; i < 5 * 1024; i += 512) { const int mi = i >> 10, k = i & 1023; const float v = mi == 0 ? as_global(P.c_ctx)[k] : as_global(P.c)[(mi - 1) * 1024 + k]; sc[i] = v / (1.f + __expf(-v)); }
    __syncthreads();
    float* MOD = (float*)(ws + WS_MOD);
    for (int u = ulo + vbid; u < uhi; u += vnb) {
        const int l = u / 72, n0 = (u % 72) * 128;
        const int kb = F.wave * 128;
        const float* W = as_global(P.mod_w) + (size_t)l * 1024 * 9216 + (size_t)kb * 9216 + n0;
        const unsigned voff = 8u * (unsigned)F.lane;
        f32x2 a0 = {0.f, 0.f}, a1 = {0.f, 0.f}, a2 = {0.f, 0.f}, a3 = {0.f, 0.f}, a4 = {0.f, 0.f};
        f32x2 wa[32];
#define MOD_LD(d, k0) _Pragma("unroll") for (int i_ = 0; i_ < 32; ++i_) asm volatile("global_load_dwordx2 %0, %1, %2" : "=v"(d[i_]) : "v"(voff), "s"(W + (size_t)((k0) + i_) * 9216) : "memory")
#define MOD_USE(d, k0) _Pragma("unroll") for (int i_ = 0; i_ < 32; ++i_) { const f32x2 w = d[i_]; const int k = kb + (k0) + i_; \
            a0 += sc[k] * w; a1 += sc[1024 + k] * w; a2 += sc[2048 + k] * w; a3 += sc[3072 + k] * w; a4 += sc[4096 + k] * w; }
        if constexpr (DBL) { f32x2 wb[32];
            MOD_LD(wa, 0); MOD_LD(wb, 32);
            mod_wait(wa, 1); MOD_USE(wa, 0); MOD_LD(wa, 64);
            mod_wait(wb, 1); MOD_USE(wb, 32); MOD_LD(wb, 96);
            mod_wait(wa, 1); MOD_USE(wa, 64);
            mod_wait(wb, 0); MOD_USE(wb, 96);
        } else {
#pragma unroll 1
            for (int k0 = 0; k0 < 128; k0 += 32) { MOD_LD(wa, k0); mod_wait(wa, 0); MOD_USE(wa, k0); }
        }
#undef MOD_LD
#undef MOD_USE
        *(LAS f32x2*)(red + (F.wave * 5 + 0) * 128 + 2 * F.lane) = a0; *(LAS f32x2*)(red + (F.wave * 5 + 1) * 128 + 2 * F.lane) = a1; *(LAS f32x2*)(red + (F.wave * 5 + 2) * 128 + 2 * F.lane) = a2;
        *(LAS f32x2*)(red + (F.wave * 5 + 3) * 128 + 2 * F.lane) = a3; *(LAS f32x2*)(red + (F.wave * 5 + 4) * 128 + 2 * F.lane) = a4;
        __syncthreads();
        for (int o = F.tid; o < 640; o += 512) { const int mi = o >> 7, c = o & 127; float s = 0.f;
#pragma unroll
            for (int w = 0; w < 8; ++w) s += red[(w * 5 + mi) * 128 + c];
            MOD[(size_t)(l * 5 + mi) * 9216 + n0 + c] = s + as_global(P.mod_b)[(size_t)l * 9216 + n0 + c]; }
        __syncthreads();
    }
}

__device__ __forceinline__ void phase_p0(const Frame& F, const Params& P, unsigned char* ws) {
    const bool shed = (F.nb == 256);
    phase_mod<true>(F, P, ws, 0, shed ? 72 : 144, F.bid, F.nb);
    LAS float* scr = (LAS float*)(F.lds + F.wave * 16384);
    conv_l0_in(F, P, 0, ws);
    if (!shed) { conv_l0_out(F, P, 0, ws); conv_l0_half(F, P, 1, ws); conv_even_out(F, P, ws); }
    if (!shed) conv_even_in(F, P, ws);
    const int gt = F.bid * 512 + F.tid, ngt = F.nb * 512;
    float* GW = (float*)(ws + WS_GW);
    for (int i = gt; i < 16 * 1024; i += ngt) { const int j = i >> 10, k = i & 1023; GW[i] = as_global(P.even_w_in)[(size_t)k * EVFULL + EVN + j]; }
    float* RT = (float*)(ws + WS_ROPE);
    for (int i = gt; i < 64 * 16; i += ngt) { const int p = i >> 4, q = i & 15;
        const float inv = __builtin_amdgcn_exp2f(-(float)q * (13.287712379549449f / 16.f)); const float ang = (float)p * inv;
        const double rev = (double)ang * 0.15915494309189533577; const float fr = (float)(rev - floor(rev));
        RT[2 * i] = __builtin_amdgcn_cosf(fr); RT[2 * i + 1] = __builtin_amdgcn_sinf(fr); }
}

constexpr int NG_LD = 1032, NG_GWB = 0, NG_HB = 16 * NG_LD * 2;
constexpr int NT_OFF = NG_HB + 2 * 16 * NG_LD * 2;
static_assert(NT_OFF + 3 * 5 * 1024 * 4 <= 163840 - 64, "norm LDS");
__device__ __forceinline__ void norm_tables(const Frame& F, const float* nw, const float* MODl, int j, const float* fmod, int fgidx, float fs) {
    LAS float* A = (LAS float*)(F.lds + NT_OFF); LAS float* B = A + 5120; LAS float* G = B + 5120;
#pragma unroll
    for (int cc = 0; cc < 2; ++cc) { const int c = F.tid + 512 * cc;
        const float w = nw[c];
        float sc[5], sh[5], gt[5];
#pragma unroll
        for (int mi = 0; mi < 5; ++mi) { sc[mi] = MODl[(size_t)(mi * 9 + 3 * j + 1) * 1024 + c]; sh[mi] = MODl[(size_t)(mi * 9 + 3 * j) * 1024 + c];
            gt[mi] = fmod ? fmod[(size_t)(mi * 9 + fgidx) * 1024 + c] : 0.f; }
#pragma unroll
        for (int mi = 0; mi < 5; ++mi) { A[mi * 1024 + c] = w * (sc[mi] + 1.f); B[mi * 1024 + c] = sh[mi]; G[mi * 1024 + c] = gt[mi] * fs; }
    }
    __syncthreads();
}
__device__ __forceinline__ void norm_finish(const Frame& F, f32x4 (&v)[4], int mi, bf16_t* orow, LAS bf16_t* hrow) {
    const LAS f32x4* A = (const LAS f32x4*)(F.lds + NT_OFF) + mi * 256 + F.lane; const LAS f32x4* B = A + 1280;
    float s = 0.f;
#pragma unroll
    for (int j = 0; j < 4; ++j) s += (v[j].x * v[j].x + v[j].y * v[j].y) + (v[j].z * v[j].z + v[j].w * v[j].w);
    const float rstd = 1.0f / sqrtf(wave_sum(s, F.lane) * (1.f / 1024.f) + EPS);
    unsigned long long* o8 = (unsigned long long*)orow + F.lane;
#pragma unroll
    for (int j = 0; j < 4; ++j) { const f32x4 y = v[j] * rstd * A[64 * j] + B[64 * j];
        const unsigned long long o = (unsigned long long)pk2(y.x, y.y) | ((unsigned long long)pk2(y.z, y.w) << 32);
        o8[64 * j] = o; if (hrow) *(LAS unsigned long long*)(hrow + 256 * j + 4 * F.lane) = o; }
}
__device__ __forceinline__ void norm_one(const Frame& F, const float* xrow, int m, int mi, const bf16_t* slab, float* xout, bf16_t* orow, LAS bf16_t* hrow) {
    f32x4 v[4];
#pragma unroll
    for (int j = 0; j < 4; ++j) v[j] = ((const f32x4*)xrow)[F.lane + 64 * j];
    if (slab && m >= 64 * 256) {
        const bf16_t* sl = slab + (size_t)(((m >> 8) - 64) * 4) * 4 * 65536 + (size_t)(m & 255) * 256 + 4 * F.lane;
        u32x2 b[4][4];
#pragma unroll
        for (int j = 0; j < 4; ++j)
#pragma unroll
            for (int q = 0; q < 4; ++q) b[j][q] = *(const u32x2*)(sl + (size_t)(j * 4 + q) * 65536);
        asm volatile("" :: "v"(v[0]), "v"(v[1]), "v"(v[2]), "v"(v[3]), "v"(b[0][0]), "v"(b[0][1]), "v"(b[0][2]), "v"(b[0][3]), "v"(b[1][0]), "v"(b[1][1]), "v"(b[1][2]), "v"(b[1][3]),
                     "v"(b[2][0]), "v"(b[2][1]), "v"(b[2][2]), "v"(b[2][3]), "v"(b[3][0]), "v"(b[3][1]), "v"(b[3][2]), "v"(b[3][3]) : "memory");
        const LAS f32x4* G = (const LAS f32x4*)(F.lds + NT_OFF) + 2560 + mi * 256 + F.lane;
#pragma unroll
        for (int j = 0; j < 4; ++j) {
            const f32x4 a0 = {bflo(b[j][0].x), bfhi(b[j][0].x), bflo(b[j][0].y), bfhi(b[j][0].y)}, a1 = {bflo(b[j][1].x), bfhi(b[j][1].x), bflo(b[j][1].y), bfhi(b[j][1].y)},
                        a2 = {bflo(b[j][2].x), bfhi(b[j][2].x), bflo(b[j][2].y), bfhi(b[j][2].y)}, a3 = {bflo(b[j][3].x), bfhi(b[j][3].x), bflo(b[j][3].y), bfhi(b[j][3].y)};
            v[j] = v[j] + G[64 * j] * ((a0 + a1) + (a2 + a3));
            ((f32x4*)xout)[F.lane + 64 * j] = v[j]; }
    }
    norm_finish(F, v, mi, orow, hrow);
}
struct TailRow { f32x4 v[4]; u32x2 b[4][4]; };
__device__ __forceinline__ void tail_load(const Frame& F, TailRow& T, const float* xrow, int m, const bf16_t* slab) {
    const bf16_t* sl = slab + (size_t)(((m >> 8) - 64) * 4) * 4 * 65536 + (size_t)(m & 255) * 256 + 4 * F.lane;
#pragma unroll
    for (int j = 0; j < 4; ++j) { T.v[j] = ((const f32x4*)xrow)[F.lane + 64 * j];
#pragma unroll
        for (int q = 0; q < 4; ++q) T.b[j][q] = *(const u32x2*)(sl + (size_t)(j * 4 + q) * 65536); }
    asm volatile("" ::: "memory");
}
__device__ __forceinline__ void tail_finish(const Frame& F, TailRow& T, int mi, float* xout, bf16_t* orow, LAS bf16_t* hrow) {
    asm volatile("" :: "v"(T.v[0]), "v"(T.v[1]), "v"(T.v[2]), "v"(T.v[3]), "v"(T.b[0][0]), "v"(T.b[0][1]), "v"(T.b[0][2]), "v"(T.b[0][3]), "v"(T.b[1][0]), "v"(T.b[1][1]), "v"(T.b[1][2]), "v"(T.b[1][3]),
                 "v"(T.b[2][0]), "v"(T.b[2][1]), "v"(T.b[2][2]), "v"(T.b[2][3]), "v"(T.b[3][0]), "v"(T.b[3][1]), "v"(T.b[3][2]), "v"(T.b[3][3]) : "memory");
    const LAS f32x4* G = (const LAS f32x4*)(F.lds + NT_OFF) + 2560 + mi * 256 + F.lane;
#pragma unroll
    for (int j = 0; j < 4; ++j) {
        const f32x4 a0 = {bflo(T.b[j][0].x), bfhi(T.b[j][0].x), bflo(T.b[j][0].y), bfhi(T.b[j][0].y)}, a1 = {bflo(T.b[j][1].x), bfhi(T.b[j][1].x), bflo(T.b[j][1].y), bfhi(T.b[j][1].y)},
                    a2 = {bflo(T.b[j][2].x), bfhi(T.b[j][2].x), bflo(T.b[j][2].y), bfhi(T.b[j][2].y)}, a3 = {bflo(T.b[j][3].x), bfhi(T.b[j][3].x), bflo(T.b[j][3].y), bfhi(T.b[j][3].y)};
        T.v[j] = T.v[j] + G[64 * j] * ((a0 + a1) + (a2 + a3));
        ((f32x4*)xout)[F.lane + 64 * j] = T.v[j]; }
    norm_finish(F, T.v, mi, orow, hrow);
}
template <bool GATES>
__device__ __forceinline__ void phase_norm_t(const Frame& F, const Params& P, unsigned char* ws, const float* xp, const float* xs, const float* xtail, int l, int j, const bf16_t* fslab, const float* fmod, int fgidx, float fs) {
    const float* MODl = (const float*)(ws + WS_MOD) + (size_t)l * 5 * 9216;
    bf16_t* XN = (bf16_t*)(ws + WS_XN);
    LAS bf16_t* GWB = (LAS bf16_t*)(F.lds + NG_GWB); LAS bf16_t* HB = (LAS bf16_t*)(F.lds + NG_HB);
    if constexpr (GATES) { const f32x4* GW = (const f32x4*)(ws + WS_GW);
        for (int i = F.tid; i < 4096; i += 512) { const f32x4 w = GW[i]; *(LAS u32x2*)(GWB + (i >> 8) * NG_LD + 4 * (i & 255)) = (u32x2){pk2(w.x, w.y), pk2(w.z, w.w)}; } }
    float* const outp = as_global(P.out); float* GATESo = (float*)(ws + WS_GATES);
#define NORM_XROW(m) ((m) < NPR ? xp + (size_t)(m) * 1024 : (((m) >= 64 * 256) ? xtail : xs) + (size_t)((m) - NPR) * 1024)
#define NORM_ISQUAD(mb) (((mb) + 3 * F.ngw < MROWS) && !(fslab && (mb) + 3 * F.ngw >= 64 * 256))
#define NORM_LOADQ(v, mb) do { _Pragma("unroll") for (int k = 0; k < 4; ++k) { const int m = (mb) + k * F.ngw; const f32x4* xr = (const f32x4*)NORM_XROW(m) + F.lane; \
            _Pragma("unroll") for (int q = 0; q < 4; ++q) v[k][q] = xr[64 * q]; } } while (0)
#define NORM_WAITQ(v) asm volatile("" :: "v"(v[0][0]), "v"(v[0][1]), "v"(v[0][2]), "v"(v[0][3]), "v"(v[1][0]), "v"(v[1][1]), "v"(v[1][2]), "v"(v[1][3]), \
                         "v"(v[2][0]), "v"(v[2][1]), "v"(v[2][2]), "v"(v[2][3]), "v"(v[3][0]), "v"(v[3][1]), "v"(v[3][2]), "v"(v[3][3]) : "memory")
#define NORM_GATES_MM(gq) do { if constexpr (GATES) { \
            __syncthreads(); \
            const int w0 = (2 * (gq)) & 7; \
            if (F.wave == w0 || F.wave == ((w0 + 1) & 7)) { \
                const int hbuf = (F.wave == w0) ? 0 : 1; \
                const LAS bf16_t* hb = HB + hbuf * 16 * NG_LD; \
                const int fr = F.lane & 15, g = F.lane >> 4; \
                f32x4 acc = {0.f, 0.f, 0.f, 0.f}; \
                _Pragma("unroll 8") for (int s = 0; s < 32; ++s) acc = mfma16(*(const LAS bf16x8*)(hb + fr * NG_LD + 32 * s + 8 * g), *(const LAS bf16x8*)(GWB + fr * NG_LD + 32 * s + 8 * g), acc); \
                _Pragma("unroll") for (int r = 0; r < 4; ++r) { const int slot = 4 * g + r, mm = F.bid * 8 + (slot & 7) + (4 * (gq) + 2 * hbuf + (slot >> 3)) * F.ngw;       \
                    if (mm < MROWS) GATESo[(size_t)mm * 16 + fr] = acc[r]; } \
            } } } while (0)
#define NORM_FINISHQ(v, mb) do { if constexpr (GATES) __syncthreads();               \
            _Pragma("unroll") for (int k = 0; k < 4; ++k) { const int m = (mb) + k * F.ngw; \
                norm_finish(F, v[k], mod_index(m), XN + (size_t)m * 1024, GATES ? HB + (k >> 1) * 16 * NG_LD + ((k & 1) * 8 + F.wave) * NG_LD : (LAS bf16_t*)nullptr); } } while (0)
    const int ngrp = (MROWS + 4 * F.ngw - 1) / (4 * F.ngw);
    const int mb0 = F.gw, mb1 = F.gw + 4 * F.ngw;
    const bool q0 = NORM_ISQUAD(mb0), q1 = q0 && ngrp > 1 && NORM_ISQUAD(mb1);
    f32x4 va[4][4], vb[4][4];
    if (q0) NORM_LOADQ(va, mb0);
    norm_tables(F, as_global(P.norm_w) + (size_t)(l * 3 + j) * 1024, MODl, j, fmod, fgidx, fs);
    int gq0 = 0;
    const int mt0 = F.gw + 8 * F.ngw, mt1 = mt0 + F.ngw;
    const bool tail2 = q0 && q1 && fslab && ngrp == 3 && mt0 >= 64 * 256 && mt1 < MROWS && mt1 + F.ngw >= MROWS;
    if (tail2) {
        NORM_LOADQ(vb, mb1);
        NORM_WAITQ(va); NORM_FINISHQ(va, mb0); NORM_GATES_MM(0);
        TailRow T0, T1;
        tail_load(F, T0, NORM_XROW(mt0), mt0, fslab);
        NORM_WAITQ(vb); NORM_FINISHQ(vb, mb1); NORM_GATES_MM(1);
        tail_load(F, T1, NORM_XROW(mt1), mt1, fslab);
        if constexpr (GATES) __syncthreads();
        tail_finish(F, T0, mod_index(mt0), outp + (size_t)mt0 * 1024, XN + (size_t)mt0 * 1024, GATES ? HB + F.wave * NG_LD : (LAS bf16_t*)nullptr);
        tail_finish(F, T1, mod_index(mt1), outp + (size_t)mt1 * 1024, XN + (size_t)mt1 * 1024, GATES ? HB + (8 + F.wave) * NG_LD : (LAS bf16_t*)nullptr);
        NORM_GATES_MM(2);
        gq0 = ngrp;
    } else if (q0) {
        if (q1) NORM_LOADQ(vb, mb1);
        NORM_WAITQ(va); NORM_FINISHQ(va, mb0); NORM_GATES_MM(0);
        gq0 = 1;
        if (q1) { NORM_WAITQ(vb); NORM_FINISHQ(vb, mb1); NORM_GATES_MM(1); gq0 = 2; }
    }
#pragma unroll 1
    for (int gq = gq0; gq < ngrp; ++gq) {
        const int mb = F.gw + 4 * gq * F.ngw;
        if (NORM_ISQUAD(mb)) {
            NORM_LOADQ(va, mb); NORM_WAITQ(va); NORM_FINISHQ(va, mb);
        } else {
            if constexpr (GATES) __syncthreads();
#pragma unroll 1
            for (int k = 0; k < 4; ++k) { const int m = mb + k * F.ngw; if (m >= MROWS) break;
                norm_one(F, NORM_XROW(m), m, mod_index(m), fslab, outp + (size_t)m * 1024, XN + (size_t)m * 1024, GATES ? HB + (k >> 1) * 16 * NG_LD + ((k & 1) * 8 + F.wave) * NG_LD : (LAS bf16_t*)nullptr); }
        }
        NORM_GATES_MM(gq);
    }
#undef NORM_GATES_MM
#undef NORM_FINISHQ
#undef NORM_WAITQ
#undef NORM_LOADQ
#undef NORM_ISQUAD
#undef NORM_XROW
}
__device__ __forceinline__ void phase_norm(const Frame& F, const Params& P, unsigned char* ws, const float* xp, const float* xs, const float* xtail, int l, int j, const bf16_t* fslab, const float* fmod, int fgidx, float fs) {
    phase_norm_t<false>(F, P, ws, xp, xs, xtail, l, j, fslab, fmod, fgidx, fs);
}
__device__ __forceinline__ void phase_norm_gates(const Frame& F, const Params& P, unsigned char* ws, const float* xp, const float* xs, const float* xtail, const bf16_t* fslab, const float* fmod, int fgidx, float fs) {
    phase_norm_t<true>(F, P, ws, xp, xs, xtail, 0, 1, fslab, fmod, fgidx, fs);
}
__device__ __forceinline__ void final_finish(const Frame& F, f32x4 (&v)[4], const f32x4 (&w)[4], f32x4* xr) {
    float s = 0.f;
#pragma unroll
    for (int j = 0; j < 4; ++j) s += (v[j].x * v[j].x + v[j].y * v[j].y) + (v[j].z * v[j].z + v[j].w * v[j].w);
    const float rstd = 1.0f / sqrtf(wave_sum(s, F.lane) * (1.f / 1024.f) + EPS);
#pragma unroll
    for (int j = 0; j < 4; ++j) xr[64 * j] = v[j] * rstd * w[j];
}
__device__ __forceinline__ void phase_final(const Frame& F, const Params& P, const bf16_t* fslab, const float* fmod, int fgidx, float fs) {
    f32x4 w[4];
#pragma unroll
    for (int q = 0; q < 4; ++q) w[q] = ((const f32x4*)as_global(P.final_norm_w))[F.lane + 64 * q];
    float* const outp = as_global(P.out);
    const int npair = fslab ? (64 * 256) : MROWS;
    int mstart = F.gw;
    {
        const int mb0 = F.gw, mb1 = F.gw + 4 * F.ngw, mt0 = F.gw + 8 * F.ngw, mt1 = mt0 + F.ngw;
        if (fslab && mb1 + 3 * F.ngw < npair && mt0 >= npair && mt1 < MROWS && mt1 + F.ngw >= MROWS) {
            f32x4 va[4][4], vb[4][4];
#define FIN_LOADQ(v, mb) do { _Pragma("unroll") for (int k = 0; k < 4; ++k) { const f32x4* xr = (const f32x4*)(outp + (size_t)((mb) + k * F.ngw) * 1024) + F.lane; \
                _Pragma("unroll") for (int j = 0; j < 4; ++j) v[k][j] = xr[64 * j]; } } while (0)
#define FIN_WAITQ(v) asm volatile("" :: "v"(v[0][0]), "v"(v[0][1]), "v"(v[0][2]), "v"(v[0][3]), "v"(v[1][0]), "v"(v[1][1]), "v"(v[1][2]), "v"(v[1][3]), \
                     "v"(v[2][0]), "v"(v[2][1]), "v"(v[2][2]), "v"(v[2][3]), "v"(v[3][0]), "v"(v[3][1]), "v"(v[3][2]), "v"(v[3][3]) : "memory")
#define FIN_FINQ(v, mb) do { _Pragma("unroll") for (int k = 0; k < 4; ++k) final_finish(F, v[k], w, (f32x4*)(outp + (size_t)((mb) + k * F.ngw) * 1024) + F.lane); } while (0)
#define FIN_TAIL(T, gt, m) do { const float* gate = fmod + (size_t)(mod_index(m) * 9 + fgidx) * 1024; \
                asm volatile("" :: "v"(T.v[0]), "v"(T.v[1]), "v"(T.v[2]), "v"(T.v[3]), "v"(T.b[0][0]), "v"(T.b[0][1]), "v"(T.b[0][2]), "v"(T.b[0][3]), "v"(T.b[1][0]), "v"(T.b[1][1]), "v"(T.b[1][2]), "v"(T.b[1][3]), \
                     "v"(T.b[2][0]), "v"(T.b[2][1]), "v"(T.b[2][2]), "v"(T.b[2][3]), "v"(T.b[3][0]), "v"(T.b[3][1]), "v"(T.b[3][2]), "v"(T.b[3][3]) : "memory"); \
                _Pragma("unroll") for (int j = 0; j < 4; ++j) { const f32x4 g4 = ((const f32x4*)gate)[F.lane + 64 * j]; \
                    const f32x4 a0 = {bflo(T.b[j][0].x), bfhi(T.b[j][0].x), bflo(T.b[j][0].y), bfhi(T.b[j][0].y)}, a1 = {bflo(T.b[j][1].x), bfhi(T.b[j][1].x), bflo(T.b[j][1].y), bfhi(T.b[j][1].y)}, \
                                a2 = {bflo(T.b[j][2].x), bfhi(T.b[j][2].x), bflo(T.b[j][2].y), bfhi(T.b[j][2].y)}, a3 = {bflo(T.b[j][3].x), bfhi(T.b[j][3].x), bflo(T.b[j][3].y), bfhi(T.b[j][3].y)}; \
                    T.v[j] = T.v[j] + g4 * fs * ((a0 + a1) + (a2 + a3)); } \
                final_finish(F, T.v, w, (f32x4*)(outp + (size_t)(m) * 1024) + F.lane); } while (0)
            FIN_LOADQ(va, mb0); FIN_LOADQ(vb, mb1);
            FIN_WAITQ(va); FIN_FINQ(va, mb0);
            TailRow T0, T1;
            tail_load(F, T0, outp + (size_t)mt0 * 1024, mt0, fslab);
            FIN_WAITQ(vb); FIN_FINQ(vb, mb1);
            tail_load(F, T1, outp + (size_t)mt1 * 1024, mt1, fslab);
            FIN_TAIL(T0, g0, mt0); FIN_TAIL(T1, g1, mt1);
#undef FIN_TAIL
#undef FIN_FINQ
#undef FIN_WAITQ
#undef FIN_LOADQ
            return;
        }
    }
    for (; mstart + 3 * F.ngw < npair; mstart += 4 * F.ngw) {
        f32x4 v[4][4];
#pragma unroll
        for (int k = 0; k < 4; ++k) { const f32x4* xr = (const f32x4*)(outp + (size_t)(mstart + k * F.ngw) * 1024) + F.lane;
#pragma unroll
            for (int j = 0; j < 4; ++j) v[k][j] = xr[64 * j]; }
        asm volatile("" :: "v"(v[0][0]), "v"(v[0][1]), "v"(v[0][2]), "v"(v[0][3]), "v"(v[1][0]), "v"(v[1][1]), "v"(v[1][2]), "v"(v[1][3]),
                     "v"(v[2][0]), "v"(v[2][1]), "v"(v[2][2]), "v"(v[2][3]), "v"(v[3][0]), "v"(v[3][1]), "v"(v[3][2]), "v"(v[3][3]) : "memory");
#pragma unroll
        for (int k = 0; k < 4; ++k) final_finish(F, v[k], w, (f32x4*)(outp + (size_t)(mstart + k * F.ngw) * 1024) + F.lane);
    }
    for (int m = mstart; m < MROWS; m += F.ngw) {
        f32x4* xr = (f32x4*)(as_global(P.out) + (size_t)m * 1024) + F.lane;
        f32x4 v[4]; float s = 0.f;
#pragma unroll
        for (int j = 0; j < 4; ++j) v[j] = xr[64 * j];
        if (fslab && m >= 64 * 256) { const int mi = mod_index(m); const float* gate = fmod + (size_t)(mi * 9 + fgidx) * 1024;
            const bf16_t* sl = fslab + (size_t)(((m >> 8) - 64) * 4) * 4 * 65536 + (size_t)(m & 255) * 256 + 4 * F.lane;
            u32x2 b[4][4]; f32x4 gt[4];
#pragma unroll
            for (int j = 0; j < 4; ++j) {
#pragma unroll
                for (int q = 0; q < 4; ++q) b[j][q] = *(const u32x2*)(sl + (size_t)(j * 4 + q) * 65536);
                gt[j] = ((const f32x4*)gate)[F.lane + 64 * j]; }
            asm volatile("" :: "v"(b[0][0]), "v"(b[0][1]), "v"(b[0][2]), "v"(b[0][3]), "v"(b[1][0]), "v"(b[1][1]), "v"(b[1][2]), "v"(b[1][3]), "v"(b[2][0]), "v"(b[2][1]), "v"(b[2][2]), "v"(b[2][3]), "v"(b[3][0]), "v"(b[3][1]), "v"(b[3][2]), "v"(b[3][3]), "v"(gt[0]), "v"(gt[1]), "v"(gt[2]), "v"(gt[3]) : "memory");
#pragma unroll
            for (int j = 0; j < 4; ++j) {
                const f32x4 a0 = {bflo(b[j][0].x), bfhi(b[j][0].x), bflo(b[j][0].y), bfhi(b[j][0].y)}, a1 = {bflo(b[j][1].x), bfhi(b[j][1].x), bflo(b[j][1].y), bfhi(b[j][1].y)},
                            a2 = {bflo(b[j][2].x), bfhi(b[j][2].x), bflo(b[j][2].y), bfhi(b[j][2].y)}, a3 = {bflo(b[j][3].x), bfhi(b[j][3].x), bflo(b[j][3].y), bfhi(b[j][3].y)};
                v[j] = v[j] + gt[j] * fs * ((a0 + a1) + (a2 + a3)); } }
#pragma unroll
        for (int j = 0; j < 4; ++j) s += (v[j].x * v[j].x + v[j].y * v[j].y) + (v[j].z * v[j].z + v[j].w * v[j].w);
        const float rstd = 1.0f / sqrtf(wave_sum(s, F.lane) * (1.f / 1024.f) + EPS);
#pragma unroll
        for (int j = 0; j < 4; ++j) xr[64 * j] = v[j] * rstd * ((const f32x4*)as_global(P.final_norm_w))[F.lane + 64 * j];
    }
}
constexpr int EC_RQ = 0, EC_RK = 256, EC_RV = 512, EC_RG = 1024, EC_GQ = 1536, EC_GK = 2048, EC_GV = 2560, EC_GG = 3072;
constexpr int S128 = 136, S64 = 72, SF = 68;
constexpr int PL_KN = 0, PL_QN = PL_KN + 64 * S128 * 2, PL_VV = PL_QN + 64 * S128 * 2;
constexpr int PL_KK = PL_VV + 64 * S128 * 2, PL_QK = PL_KK + 64 * SF * 4;
constexpr int PL_M = PL_KK + 34816;
constexpr int PL_TB = PL_M + 34816;
constexpr int PL_GC = PL_TB + 4 * 64 * S64 * 2;
constexpr int PL_END = PL_GC + 6 * 64 * 4;
static_assert(PL_END <= 163840 - 1024, "prep LDS");


__device__ __forceinline__ float rdlane(float v, int l) { return __builtin_bit_cast(float, __builtin_amdgcn_readlane(__builtin_bit_cast(int, v), l)); }
struct TriGrp { float t0, t1; f32x4 m[8]; };
__device__ __forceinline__ void tri_ld(TriGrp& G, const LAS float* MT, const LAS float* TL, int j, int b, int lane) {
    G.t0 = TL[j * SF + lane]; G.t1 = TL[(j + 1) * SF + lane];
    const LAS f32x4* p0 = (const LAS f32x4*)(MT + j * SF + 16 * b); const LAS f32x4* p1 = (const LAS f32x4*)(MT + (j + 1) * SF + 16 * b);
    G.m[0] = p0[0]; G.m[1] = p0[1]; G.m[2] = p0[2]; G.m[3] = p0[3]; G.m[4] = p1[0]; G.m[5] = p1[1]; G.m[6] = p1[2]; G.m[7] = p1[3];
}
__device__ __forceinline__ void tri_fma(f32x2 (&acc)[8], const TriGrp& G) {
#pragma unroll
    for (int k = 0; k < 4; ++k) { acc[2 * k] += (f32x2){G.m[k].x, G.m[k].y} * G.t0; acc[2 * k + 1] += (f32x2){G.m[k].z, G.m[k].w} * G.t0; }
#pragma unroll
    for (int k = 0; k < 4; ++k) { acc[2 * k] += (f32x2){G.m[4 + k].x, G.m[4 + k].y} * G.t1; acc[2 * k + 1] += (f32x2){G.m[4 + k].z, G.m[4 + k].w} * G.t1; }
}
__device__ __forceinline__ void tri_inverse(const LAS float* MT, LAS float* TL, LAS bf16_t* TBu, LAS bf16_t* TBw, float su, float sw, int cpos, int lane) {
#pragma unroll
    for (int b = 0; b < 4; ++b) {
        asm volatile("" : "+v"(lane));
        f32x2 acc[8];
#pragma unroll
        for (int r = 0; r < 8; ++r) acc[r] = (f32x2){0.f, 0.f};
        if (b > 0) {
            TriGrp GA, GB;
            tri_ld(GA, MT, TL, 0, b, lane);
#pragma unroll 1
            for (int j = 0; j < 16 * b; j += 4) {
                tri_ld(GB, MT, TL, j + 2, b, lane);
                tri_fma(acc, GA);
                tri_ld(GA, MT, TL, (j + 4 < 16 * b) ? j + 4 : 0, b, lane);
                tri_fma(acc, GB);
            }
        }
        f32x4 mq[4];
        { const LAS f32x4* dp = (const LAS f32x4*)(MT + (16 * b + (lane & 15)) * SF + 16 * b); mq[0] = dp[0]; mq[1] = dp[1]; mq[2] = dp[2]; mq[3] = dp[3]; }
        float T[16];
#pragma unroll
        for (int r = 0; r < 16; ++r) T[r] = ((lane == 16 * b + r) ? 1.f : 0.f) - acc[r >> 1][r & 1];
#pragma unroll
        for (int q = 0; q < 15; ++q) {
#pragma unroll
            for (int r = q + 1; r < 16; ++r) T[r] -= rdlane(mq[r >> 2][r & 3], q) * T[q];
        }
#pragma unroll
        for (int r = 0; r < 16; ++r) { TL[(16 * b + r) * SF + lane] = T[r]; const f32x2 t2 = (f32x2){su, sw} * T[r]; const unsigned w2 = pk2(t2.x, t2.y);
            TBu[(16 * b + r) * S64 + cpos] = (bf16_t)(w2 & 0xffffu); TBw[(16 * b + r) * S64 + cpos] = (bf16_t)(w2 >> 16); }
    }
}

constexpr int PA_NR = 11;
struct PrepRows { unsigned q[PA_NR], k[PA_NR], v[PA_NR]; };
__device__ __forceinline__ void prep_rows_compute(PrepRows& R, const Params& P, unsigned char* ws, int chunk, int h, int wave, int lane) {
    const bf16_t* E = (const bf16_t*)(ws + WS_BIG);
    const int row0 = chunk * 64, cps = chunk < 64 ? 4 : 64, cis = chunk < 64 ? (chunk & 3) : ((chunk - 64) & 63);
    const int p0 = PA_NR * (wave - 2), nr = (wave == 7) ? 64 - PA_NR * 5 : PA_NR;
    float cw[3][3][2];
#pragma unroll
    for (int t = 0; t < 3; ++t)
#pragma unroll
        for (int j = 0; j < 3; ++j) { const f32x2 w = *(const f32x2*)(as_global(P.gdn_conv_w) + (size_t)j * 1536 + t * 512 + h * 128 + 2 * lane); cw[t][j][0] = w.x; cw[t][j][1] = w.y; }
    unsigned wr[3][PA_NR + 2];
#pragma unroll
    for (int i = 0; i < PA_NR + 2; ++i) { const int pp = p0 - 1 + i; const bool ok = (pp >= 0 || cis > 0) && (pp < 64 || (pp == 64 && cis < cps - 1));
        const bf16_t* src = E + (size_t)(row0 + (ok ? pp : p0)) * EVN + EC_GQ + h * 128 + 2 * lane;
#pragma unroll
        for (int t = 0; t < 3; ++t) asm volatile("global_load_dword %0, %1, off offset:%c2" : "=v"(wr[t][i]) : "v"(src), "i"(t * 1024) : "memory"); }
    asm volatile("s_waitcnt vmcnt(0)" : "+v"(wr[0][0]), "+v"(wr[0][1]), "+v"(wr[0][2]), "+v"(wr[0][3]), "+v"(wr[0][4]), "+v"(wr[0][5]), "+v"(wr[0][6]), "+v"(wr[0][7]), "+v"(wr[0][8]), "+v"(wr[0][9]), "+v"(wr[0][10]), "+v"(wr[0][11]), "+v"(wr[0][12]) :: "memory");
    asm volatile("" : "+v"(wr[1][0]), "+v"(wr[1][1]), "+v"(wr[1][2]), "+v"(wr[1][3]), "+v"(wr[1][4]), "+v"(wr[1][5]), "+v"(wr[1][6]), "+v"(wr[1][7]), "+v"(wr[1][8]), "+v"(wr[1][9]), "+v"(wr[1][10]), "+v"(wr[1][11]), "+v"(wr[1][12]));
    asm volatile("" : "+v"(wr[2][0]), "+v"(wr[2][1]), "+v"(wr[2][2]), "+v"(wr[2][3]), "+v"(wr[2][4]), "+v"(wr[2][5]), "+v"(wr[2][6]), "+v"(wr[2][7]), "+v"(wr[2][8]), "+v"(wr[2][9]), "+v"(wr[2][10]), "+v"(wr[2][11]), "+v"(wr[2][12]));
#pragma unroll
    for (int i = 0; i < PA_NR + 2; ++i) { const int pp = p0 - 1 + i;
        if ((pp < 0 && cis == 0) || (pp > 63 && cis == cps - 1)) {
#pragma unroll
            for (int t = 0; t < 3; ++t) wr[t][i] = 0u; } }
#pragma unroll
    for (int rr = 0; rr < PA_NR; ++rr) {
        if (rr < nr) {
            float y[3][2];
#pragma unroll
            for (int t = 0; t < 3; ++t) { const unsigned w0 = wr[t][rr], w1 = wr[t][rr + 1], w2 = wr[t][rr + 2];
                y[t][0] = silu_f(cw[t][0][0] * bflo(w0) + cw[t][1][0] * bflo(w1) + cw[t][2][0] * bflo(w2));
                y[t][1] = silu_f(cw[t][0][1] * bfhi(w0) + cw[t][1][1] * bfhi(w1) + cw[t][2][1] * bfhi(w2)); }
            const float sq = wave_sum(y[0][0] * y[0][0] + y[0][1] * y[0][1], lane), sk = wave_sum(y[1][0] * y[1][0] + y[1][1] * y[1][1], lane);
            const float rq = (1.0f / sqrtf(sq + EPS)) * 0.08838834764831845f, rk = 1.0f / sqrtf(sk + EPS);
            R.q[rr] = pk2(y[0][0] * rq, y[0][1] * rq); R.k[rr] = pk2(y[1][0] * rk, y[1][1] * rk); R.v[rr] = pk2(y[2][0], y[2][1]);
        } else { R.q[rr] = 0u; R.k[rr] = 0u; R.v[rr] = 0u; }
    }
}
__device__ __forceinline__ void prep_rows_commit(const PrepRows& R, LAS unsigned char* L, unsigned char* ws, int chunk, int h, int wave, int lane) {
    LAS bf16_t* KN = (LAS bf16_t*)(L + PL_KN); LAS bf16_t* QN = (LAS bf16_t*)(L + PL_QN); LAS bf16_t* VV = (LAS bf16_t*)(L + PL_VV);
    bf16_t* qn_g = (bf16_t*)(ws + WS_QN);
    const int p0 = PA_NR * (wave - 2), nr = (wave == 7) ? 64 - PA_NR * 5 : PA_NR;
#pragma unroll
    for (int rr = 0; rr < PA_NR; ++rr) { if (rr < nr) { const int p = p0 + rr;
        *(LAS unsigned*)(QN + p * S128 + 2 * lane) = R.q[rr]; *(LAS unsigned*)(KN + p * S128 + 2 * lane) = R.k[rr]; *(LAS unsigned*)(VV + p * S128 + 2 * lane) = R.v[rr];
        *(unsigned*)(qn_g + (size_t)(chunk * 64 + p) * 512 + h * 128 + 2 * lane) = R.q[rr]; } }
}
struct PrepGates { float a, b, dt, al; };
__device__ __forceinline__ void prep_gates_load(PrepGates& G, const Params& P, unsigned char* ws, int chunk, int h, int wave, int lane) {
    const int pos = wave ? 63 - lane : lane; const float* gt = (const float*)(ws + WS_GATES) + (size_t)(chunk * 64 + pos) * 16;
    G.a = gt[wave * 4 + h]; G.b = gt[8 + wave * 4 + h]; G.dt = as_global(P.gdn_dt_bias)[wave * 4 + h]; G.al = as_global(P.gdn_A_log)[wave * 4 + h];
}
__device__ __forceinline__ void prep_gates_commit(const PrepGates& G, LAS unsigned char* L, unsigned char* ws, int chunk, int h, int wave, int lane) {
    LAS float* GCS = (LAS float*)(L + PL_GC); LAS float* BET = GCS + 128; LAS float* EGC = GCS + 256;
    const int dir = wave, pr = lane;
    const float xg = G.a + G.dt;
    const float sp = fmaxf(xg, 0.f) + __logf(1.f + __expf(-fabsf(xg)));
    float gc = -__expf(G.al) * sp;
#pragma unroll
    for (int o = 1; o < 64; o <<= 1) { const float t = __builtin_bit_cast(float, __builtin_amdgcn_ds_bpermute((lane - o) << 2, __builtin_bit_cast(int, gc))); if (lane >= o) gc += t; }
    GCS[dir * 64 + pr] = gc; BET[dir * 64 + pr] = sigmoid_f(G.b); EGC[dir * 64 + pr] = __expf(gc);
    ((float*)(ws + WS_GC))[((size_t)(dir * NCHUNK + chunk) * 4 + h) * 64 + pr] = gc;
}
__device__ __forceinline__ void phase_gdn_prep(const Frame& F, const Params& P, unsigned char* ws, int skip) {
    (void)skip;
    LAS unsigned char* L = F.lds;
    LAS bf16_t* KN = (LAS bf16_t*)(L + PL_KN); LAS bf16_t* QN = (LAS bf16_t*)(L + PL_QN); LAS bf16_t* VV = (LAS bf16_t*)(L + PL_VV);
    LAS float* KK = (LAS float*)(L + PL_KK);
    LAS float* MM = (LAS float*)(L + PL_M); LAS bf16_t* TB = (LAS bf16_t*)(L + PL_TB);
    LAS float* GCS = (LAS float*)(L + PL_GC); LAS float* BET = GCS + 128; LAS float* EGC = GCS + 256;
    const int wave = F.wave;
    int u = F.bid;
    if (u >= NCHUNK * 4) return;
    {
        const int lane = fresh_lane();
        if (wave >= 2) { PrepRows R; prep_rows_compute(R, P, ws, u >> 2, u & 3, wave, lane); prep_rows_commit(R, L, ws, u >> 2, u & 3, wave, lane); }
        else { PrepGates G; prep_gates_load(G, P, ws, u >> 2, u & 3, wave, lane); prep_gates_commit(G, L, ws, u >> 2, u & 3, wave, lane); }
    }
#pragma unroll 1
    for (; u < NCHUNK * 4; u += F.nb) {
        const int chunk = u >> 2, h = u & 3, un = u + F.nb; const bool has_next = un < NCHUNK * 4;
        const int lane = fresh_lane(), tid = wave * 64 + lane, fr = lane & 15, g = lane >> 4;
        __syncthreads();
        {
            const int dk = tid >> 2, pb = tid & 3; unsigned w[8];
#pragma unroll
            for (int i = 0; i < 8; ++i) w[i] = (unsigned)KN[(16 * pb + 2 * i) * S128 + dk] | ((unsigned)KN[(16 * pb + 2 * i + 1) * S128 + dk] << 16);
            u32x4* dst = (u32x4*)((bf16_t*)(ws + WS_KNT) + ((size_t)(chunk * 4 + h) * 128 + dk) * 64 + 16 * pb);
            dst[0] = (u32x4){w[0], w[1], w[2], w[3]}; dst[1] = (u32x4){w[4], w[5], w[6], w[7]};
        }
        {
            bf16_t* ATT = (bf16_t*)(ws + WS_ATT);
#pragma unroll
            for (int e = 0; e < 2; ++e) {
                const int tt = 2 * wave + e, mt = tt >> 2, nt = tt & 3;
                f32x4 ak = {0.f, 0.f, 0.f, 0.f}, aq = {0.f, 0.f, 0.f, 0.f};
#pragma unroll
                for (int s = 0; s < 4; ++s) {
                    const bf16x8 a1 = *(const LAS bf16x8*)(KN + (16 * nt + fr) * S128 + 32 * s + 8 * g);
                    const bf16x8 bk = *(const LAS bf16x8*)(KN + (16 * mt + fr) * S128 + 32 * s + 8 * g);
                    const bf16x8 bq = *(const LAS bf16x8*)(QN + (16 * mt + fr) * S128 + 32 * s + 8 * g);
                    ak = mfma16(a1, bk, ak); aq = mfma16(a1, bq, aq);
                }
                const int pi = 16 * mt + fr, pj0 = 16 * nt + 4 * g;
#pragma unroll
                for (int dir = 0; dir < 2; ++dir) {
                    const int i = dir ? 63 - pi : pi, jb = dir ? 60 - pj0 : pj0;
                    bf16_t* ap = ATT + ((size_t)(dir * NCHUNK + chunk) * 4 + h) * 4096 + i * 64 + jb;
                    if (dir ? (nt < mt) : (nt > mt)) { *(u32x2*)ap = (u32x2){0u, 0u}; continue; }
                    const float gi = GCS[dir * 64 + i], be = BET[dir * 64 + i];
                    const f32x4 gj = *(const LAS f32x4*)(GCS + dir * 64 + jb);
                    float at[4];
#pragma unroll
                    for (int r = 0; r < 4; ++r) { const int q = dir ? 3 - r : r, j = jb + q;
                        const float dec = (j <= i) ? __expf(gi - gj[q]) : 0.f;
                        at[q] = aq[r] * dec;
                        if (j < i) MM[dir * 64 * SF + j * SF + i] = be * ak[r] * dec; }
                    *(u32x2*)ap = (u32x2){pk2(at[0], at[1]), pk2(at[2], at[3])};
                }
            }
        }
        __syncthreads();
        PrepRows R; PrepGates G;
        if (wave < 2) {
            if (has_next) prep_gates_load(G, P, ws, un >> 2, un & 3, wave, lane);
            const float be = BET[wave * 64 + lane];
            tri_inverse(MM + wave * 64 * SF, KK + wave * 64 * SF, TB + (wave * 2 + 0) * 64 * S64, TB + (wave * 2 + 1) * 64 * S64, be, be * EGC[wave * 64 + lane], wave ? 63 - lane : lane, lane);
        } else if (has_next) prep_rows_compute(R, P, ws, un >> 2, un & 3, wave, lane);
        __syncthreads();
        {
            const int dir = wave >> 2, var = (wave >> 1) & 1;
            const LAS bf16_t* SRC = var ? KN : VV; const LAS bf16_t* TT = TB + (dir * 2 + var) * 64 * S64;
            bf16_t* OG = (bf16_t*)(ws + (var ? WS_W : WS_U)) + ((size_t)(dir * NCHUNK + chunk) * 4 + h) * 8192;
            bf16x8 bfr[4][2];
#pragma unroll
            for (int it = 0; it < 4; ++it)
#pragma unroll
                for (int s2 = 0; s2 < 2; ++s2) bfr[it][s2] = *(const LAS bf16x8*)(TT + (16 * it + fr) * S64 + 32 * s2 + 8 * g);
            const int tq = (lane & 15) >> 2, tp = lane & 3;
#pragma unroll
            for (int e = 0; e < 4; ++e) { const int ct = 4 * (wave & 1) + e;
                bf16x8 afr[2];
#pragma unroll
                for (int s2 = 0; s2 < 2; ++s2) { const LAS bf16_t* ap = SRC + (32 * s2 + 8 * g + tq) * S128 + 16 * ct + 4 * tp;
                    const s16x4 lo = __builtin_bit_cast(s16x4, __builtin_amdgcn_ds_read_tr16_b64_v4i16((LAS s16x4*)ap)), hi = __builtin_bit_cast(s16x4, __builtin_amdgcn_ds_read_tr16_b64_v4i16((LAS s16x4*)(ap + 4 * S128)));
                    afr[s2] = (bf16x8){lo[0], lo[1], lo[2], lo[3], hi[0], hi[1], hi[2], hi[3]}; }
#pragma unroll
                for (int it = 0; it < 4; ++it) { f32x4 acc = {0.f, 0.f, 0.f, 0.f};
#pragma unroll
                    for (int s2 = 0; s2 < 2; ++s2) acc = mfma16(afr[s2], bfr[it][s2], acc);
                    const int i = 16 * it + fr, c = 16 * ct + 4 * g;
                    *(u32x2*)(OG + i * 128 + c) = (u32x2){pk2(acc[0], acc[1]), pk2(acc[2], acc[3])}; }
            }
        }
        __syncthreads();
        if (has_next) { if (wave >= 2) prep_rows_commit(R, L, ws, un >> 2, un & 3, wave, lane); else prep_gates_commit(G, L, ws, un >> 2, un & 3, wave, lane); }
    }
    __syncthreads();
}
#ifndef SCAN_PROBE
#define SCAN_PROBE 0
#endif
constexpr int SL_QD = 0, SL_WW = 17408, SL_UU = 34816, SL_KDT = 52224, SL_AT = 70656;
constexpr int SL_OO = 79872, SL_EG = 79872 + 17408;
constexpr int SL_GCP = 98304;
constexpr int SL_QNAT = 9216, SL_KNAT = 18432;

__device__ __forceinline__ int kperm(int c) { return (c & ~31) | ((c & 12) << 1) | ((c & 16) >> 2) | (c & 3); }
__device__ __forceinline__ bf16x8 afrag(const LAS bf16_t* T, int stride, int rowbase, int s, int fr, int g) {
    return *(const LAS bf16x8*)(T + (rowbase + fr) * stride + 32 * s + 8 * g);
}
__device__ __forceinline__ void st_perm8(LAS bf16_t* row, int k0, u32x4 v) {
    *(LAS u32x2*)(row + kperm(k0)) = (u32x2){v.x, v.y}; *(LAS u32x2*)(row + kperm(k0 + 4)) = (u32x2){v.z, v.w};
}
__device__ __forceinline__ u32x4 scale8(u32x4 v, float s) {
    u32x4 o; o.x = pk2(bflo(v.x) * s, bfhi(v.x) * s); o.y = pk2(bflo(v.y) * s, bfhi(v.y) * s); o.z = pk2(bflo(v.z) * s, bfhi(v.z) * s); o.w = pk2(bflo(v.w) * s, bfhi(v.w) * s); return o;
}

struct ScanPF { u32x4 q[2], w[2], u[2], k[2], a; };
__device__ __forceinline__ void gl16(u32x4& d, const void* p) { asm volatile("global_load_dwordx4 %0, %1, off" : "=v"(d) : "v"(p) : "memory"); }
__device__ __forceinline__ void gl4(float& d, const void* p) { asm volatile("global_load_dword %0, %1, off" : "=v"(d) : "v"(p) : "memory"); }
__device__ __forceinline__ void glds4(const void* gsrc, unsigned lds_dst) { unsigned keep;
    asm volatile("s_mov_b32 %0, m0\n\ts_mov_b32 m0, %2\n\ts_nop 0\n\tglobal_load_lds_dword %1, off\n\ts_mov_b32 m0, %0" : "=&s"(keep) : "v"(gsrc), "s"(lds_dst) : "memory"); }
__device__ __forceinline__ void gl16s(u32x4& d, const void* sbase, unsigned voff) { asm volatile("global_load_dwordx4 %0, %1, %2" : "=v"(d) : "v"(voff), "s"(sbase) : "memory"); }
__device__ __forceinline__ void glds4s(const void* sbase, unsigned voff, unsigned lds_dst) { unsigned keep;
    asm volatile("s_mov_b32 %0, m0\n\ts_mov_b32 m0, %3\n\ts_nop 0\n\tglobal_load_lds_dword %1, %2\n\ts_mov_b32 m0, %0" : "=&s"(keep) : "v"(voff), "s"(sbase), "s"(lds_dst) : "memory"); }
struct ScanOff { unsigned q[2], wu[2], k[2], a, gc; };
template <bool GDN>
__device__ __forceinline__ void scan_offsets(ScanOff& o, int tid, int dir, int h) {
    if constexpr (GDN) {
#pragma unroll
        for (int k = 0; k < 2; ++k) { const int it = tid + 512 * k, pr = it >> 4, cc = it & 15, pos = dir ? 63 - pr : pr;
            o.q[k] = (unsigned)(pos * 512 + h * 128 + 8 * cc) * 2u; o.wu[k] = (unsigned)(pr * 128 + 8 * cc) * 2u; }
#pragma unroll
        for (int k = 0; k < 2; ++k) { const int it = tid + 512 * k, dk = it >> 3, c8 = it & 7; o.k[k] = (unsigned)(dk * 64 + 8 * c8) * 2u; }
        { const int pr = tid >> 3, c8 = tid & 7; o.a = (unsigned)(pr * 64 + 8 * c8) * 2u; }
        o.gc = (unsigned)(tid & 63) * 4u;
    } else {
        { const int pr = tid >> 3, cc = tid & 7, pos = dir ? 63 - pr : pr; o.q[0] = (unsigned)(pos * EVN + h * 64 + 8 * cc) * 2u; }
#pragma unroll
        for (int k = 0; k < 2; ++k) { const int it = tid + 512 * k, pr = it >> 4, cc = it & 15, pos = dir ? 63 - pr : pr; o.wu[k] = (unsigned)(pos * EVN + EC_RV + h * 128 + 8 * cc) * 2u; }
        o.q[1] = o.k[0] = o.k[1] = o.a = o.gc = 0u;
    }
}
template <bool GDN, bool FULL>
__device__ __forceinline__ void scan_load(ScanPF& p, unsigned char* ws, const bf16_t* E, const ScanOff& o, int dir, int h, int chunk, unsigned gcslot) {
    const int row0 = chunk * 64;
    if constexpr (GDN) {
        const float* GCg = (const float*)(ws + WS_GC) + ((size_t)(dir * NCHUNK + chunk) * 4 + h) * 64;
        const bf16_t* qn = (const bf16_t*)(ws + WS_QN) + (size_t)row0 * 512; const bf16_t* knT = (const bf16_t*)(ws + WS_KNT) + (size_t)(chunk * 4 + h) * 128 * 64;
        const bf16_t* UG = (const bf16_t*)(ws + WS_U) + ((size_t)(dir * NCHUNK + chunk) * 4 + h) * 8192;
        const bf16_t* WG = (const bf16_t*)(ws + WS_W) + ((size_t)(dir * NCHUNK + chunk) * 4 + h) * 8192;
        const bf16_t* AG = (const bf16_t*)(ws + WS_ATT) + ((size_t)(dir * NCHUNK + chunk) * 4 + h) * 4096;
        glds4s(GCg, o.gc, gcslot);
#pragma unroll
        for (int k = 0; k < 2; ++k) {
            if constexpr (FULL) gl16s(p.q[k], qn, o.q[k]);
            gl16s(p.w[k], WG, o.wu[k]); gl16s(p.u[k], UG, o.wu[k]); }
#pragma unroll
        for (int k = 0; k < 2; ++k) gl16s(p.k[k], knT, o.k[k]);
        if constexpr (FULL) gl16s(p.a, AG, o.a);
    } else {
        const bf16_t* er = E + (size_t)row0 * EVN;
        if constexpr (FULL) gl16s(p.q[0], er + EC_RQ, o.q[0]);
        gl16s(p.k[0], er + EC_RK, o.q[0]);
#pragma unroll
        for (int k = 0; k < 2; ++k) gl16s(p.u[k], er, o.wu[k]);
    }
}
template <bool GDN, bool FULL, int N>
__device__ __forceinline__ void scan_wait(ScanPF& p) {
    if constexpr (GDN && FULL) asm volatile("s_waitcnt vmcnt(%c9)" : "+v"(p.q[0]), "+v"(p.q[1]), "+v"(p.w[0]), "+v"(p.w[1]), "+v"(p.u[0]), "+v"(p.u[1]), "+v"(p.k[0]), "+v"(p.k[1]), "+v"(p.a) : "i"(N) : "memory");
    else if constexpr (GDN) asm volatile("s_waitcnt vmcnt(%c6)" : "+v"(p.w[0]), "+v"(p.w[1]), "+v"(p.u[0]), "+v"(p.u[1]), "+v"(p.k[0]), "+v"(p.k[1]) : "i"(N) : "memory");
    else if constexpr (FULL) asm volatile("s_waitcnt vmcnt(%c4)" : "+v"(p.q[0]), "+v"(p.k[0]), "+v"(p.u[0]), "+v"(p.u[1]) : "i"(N) : "memory");
    else asm volatile("s_waitcnt vmcnt(%c3)" : "+v"(p.k[0]), "+v"(p.u[0]), "+v"(p.u[1]) : "i"(N) : "memory");
}
__device__ __forceinline__ u32x4 rev8(u32x4 v) {
    return (u32x4){(v.w >> 16) | (v.w << 16), (v.z >> 16) | (v.z << 16), (v.y >> 16) | (v.y << 16), (v.x >> 16) | (v.x << 16)};
}
constexpr int SGL = 16, SNG = 64 / SGL;
constexpr size_t WS_SGB = 327 * MiB;
constexpr size_t WS_DLT = 343 * MiB;
constexpr size_t WS_CG = 351 * MiB;
constexpr size_t WS_HEND = 351 * MiB + 4096;

template <bool GDN, int MODE>
__device__ __forceinline__ void scan_unit(const Frame& F, const Params& P, unsigned char* ws, int seq, int h, int dir, int gi, bool dummy) {
    constexpr int DK = GDN ? 128 : 64, NDT = DK / 16, NKS = DK / 32, SQ = GDN ? S128 : S64;
    constexpr bool FULL = (MODE != 1), latent = (MODE != 0), TRK = (GDN && MODE == 1);
    LAS unsigned char* L = F.lds;
    LAS bf16_t* QD = (LAS bf16_t*)(L + SL_QD); LAS bf16_t* WW = (LAS bf16_t*)(L + SL_WW); LAS bf16_t* UU = (LAS bf16_t*)(L + SL_UU);
    LAS bf16_t* KDT = (LAS bf16_t*)(L + SL_KDT); LAS bf16_t* AT = (LAS bf16_t*)(L + SL_AT);
    LAS bf16_t* OO = (LAS bf16_t*)(L + SL_OO); LAS float* EGS = (LAS float*)(L + SL_EG); LAS float* DKS = EGS + 64;
    LAS bf16_t* KNAT = (LAS bf16_t*)(L + SL_KNAT);
    const int wave = F.wave;
    int lane = fresh_lane(), tid = wave * 64 + lane, fr = lane & 15, g = lane >> 4, col = 16 * wave + fr;
    const int cb = latent ? 64 + 64 * seq : 4 * seq, nch = latent ? 64 : 4, n0 = latent ? SGL * gi : 0, ns = latent ? SGL : 4;
    const int ci = (seq * 4 + h) * 2 + dir;
    bf16_t* E = (bf16_t*)(ws + WS_BIG);
    float* sgb = GDN ? (float*)(ws + WS_SGB) + ((size_t)ci * SNG + gi) * 16384 : as_global(P.out) + OUT_CK + ((size_t)ci * SNG + gi) * 8192;
    f32x4 S[NDT], D[TRK ? NDT : 1];
    if constexpr (MODE == 3) {
        { const float* s0 = (GDN ? as_global(P.state_gdn) : as_global(P.state_ret)) + (size_t)((seq * 2 + dir) * 4 + h) * DK * 128;
#pragma unroll
          for (int dt = 0; dt < NDT; ++dt)
#pragma unroll
              for (int r = 0; r < 4; ++r) S[dt][r] = s0[(16 * dt + 4 * g + r) * 128 + col]; }
        if constexpr (GDN) {
            LAS bf16_t* DT0 = (LAS bf16_t*)L;
            if (gi > 0) {
                __syncthreads();
#pragma unroll 1
                for (int gq = 0; gq < gi; ++gq) { const bf16_t* dl = (const bf16_t*)(ws + WS_DLT) + ((size_t)ci * SNG + gq) * 16384;
#pragma unroll
                    for (int k = 0; k < 4; ++k) { const int it = tid + 512 * k, rr = it >> 4, cc = it & 15; *(LAS u32x4*)(DT0 + gq * (128 * S128) + rr * S128 + 8 * cc) = *(const u32x4*)(dl + rr * 128 + 8 * cc); } }
                f32x4 B[NDT], Bn[NDT];
                { const float* bg = sgb - (ptrdiff_t)gi * 16384;
#pragma unroll
                  for (int dt = 0; dt < NDT; ++dt)
#pragma unroll
                      for (int r = 0; r < 4; ++r) B[dt][r] = bg[(16 * dt + 4 * g + r) * 128 + col]; }
                __syncthreads();
#pragma unroll 1
                for (int gq = 0; gq < gi; ++gq) {
                    const float c = ((const float*)(ws + WS_CG))[ci * SNG + gq];
                    { const float* bg = sgb + ((ptrdiff_t)(gq + 1 < gi ? gq + 1 : gq) - gi) * 16384;
#pragma unroll
                      for (int dt = 0; dt < NDT; ++dt)
#pragma unroll
                          for (int r = 0; r < 4; ++r) Bn[dt][r] = bg[(16 * dt + 4 * g + r) * 128 + col]; }
                    const LAS bf16_t* DT = DT0 + gq * (128 * S128);
                    bf16x8 Sb[NKS];
#pragma unroll
                    for (int s2 = 0; s2 < NKS; ++s2) Sb[s2] = pack8(S[2 * s2], S[2 * s2 + 1]);
#pragma unroll
                    for (int dt = 0; dt < NDT; ++dt) { f32x4 t = S[dt] * c + B[dt];
#pragma unroll
                        for (int s2 = 0; s2 < NKS; ++s2) t = mfma16(afrag(DT, S128, 16 * dt, s2, fr, g), Sb[s2], t);
                        S[dt] = t; }
#pragma unroll
                    for (int dt = 0; dt < NDT; ++dt) B[dt] = Bn[dt];
                }
            }
        } else {
            const float x = as_global(P.ret_decay_logit)[dir * 4 + h]; const float cret = __expf((float)(64 * SGL) * -(fmaxf(-x, 0.f) + __logf(1.f + __expf(-fabsf(x)))));
            f32x4 B[SNG - 1][NDT];
#pragma unroll
            for (int gq = 0; gq < SNG - 1; ++gq) { const float* bg = sgb + ((ptrdiff_t)(gq < gi ? gq : 0) - gi) * 8192;
#pragma unroll
                for (int dt = 0; dt < NDT; ++dt)
#pragma unroll
                    for (int r = 0; r < 4; ++r) B[gq][dt][r] = (gq < gi) ? bg[(16 * dt + 4 * g + r) * 128 + col] : 0.f; }
#pragma unroll
            for (int gq = 0; gq < SNG - 1; ++gq) { if (gq < gi) {
#pragma unroll
                for (int dt = 0; dt < NDT; ++dt) S[dt] = S[dt] * cret + B[gq][dt]; } }
        }
        __syncthreads();
    } else {
#pragma unroll
        for (int dt = 0; dt < NDT; ++dt) S[dt] = (f32x4){0.f, 0.f, 0.f, 0.f};
    }
    if constexpr (TRK) {
#pragma unroll
        for (int dt = 0; dt < NDT; ++dt) D[dt] = (f32x4){0.f, 0.f, 0.f, 0.f};
    }
    float crun = 1.f;
    float lg = 0.f;
    if (!GDN) { const float x = as_global(P.ret_decay_logit)[dir * 4 + h]; lg = -(fmaxf(-x, 0.f) + __logf(1.f + __expf(-fabsf(x)))); }
#define CHUNK_OF(nn) (dir ? cb + nch - 1 - (n0 + (nn)) : cb + n0 + (nn))
#define SCAN_STORE_O(cprev) do { const int chunkp_ = (cprev); \
        _Pragma("unroll") for (int k = 0; k < 2; ++k) { const int it = tid + 512 * k, pr = it >> 4, cc = it & 15; \
            const u32x4 v = *(const LAS u32x4*)(OO + pr * S128 + 8 * cc); \
            if (dummy) *(u32x4*)((bf16_t*)(ws + WS_HEND + MiB) + ((((size_t)chunkp_ * 4 + h) * 8192 + pr * 128 + 8 * cc) & 0x3fff8)) = v; \
            else if constexpr (GDN) *(u32x4*)((bf16_t*)(ws + WS_U) + ((size_t)(dir * NCHUNK + chunkp_) * 4 + h) * 8192 + pr * 128 + 8 * cc) = v; \
            else { const int pos = dir ? 63 - pr : pr; *(u32x4*)(E + (size_t)(chunkp_ * 64 + pos) * EVN + (dir ? EC_GK : EC_GQ) + h * 128 + 8 * cc) = v; } } } while (0)
#define SCAN_BAR() asm volatile("s_waitcnt lgkmcnt(0)\n\ts_barrier" ::: "memory")
#define SCAN_STEP(PFS, SET, n_, NWAIT) do { const int n = (n_); \
          \
        float gcl; \
        SCAN_BAR(); \
        scan_wait<GDN, FULL, NWAIT>(PFS); \
        if constexpr (GDN) { \
            { const LAS float* gsl = (const LAS float*)(L + SL_GCP) + (SET) * 64; gcl = gsl[63]; \
              if (tid < 64) { const float gc_ = gsl[tid]; EGS[tid] = __expf(gc_); DKS[tid] = __expf(gcl - gc_); } } \
            _Pragma("unroll") for (int k = 0; k < 2; ++k) { const int it = tid + 512 * k, pr = it >> 4, cc = it & 15; \
                if constexpr (FULL) st_perm8(QD + pr * S128, 8 * cc, PFS.q[k]); \
                st_perm8(WW + pr * S128, 8 * cc, PFS.w[k]); \
                *(LAS u32x4*)(UU + pr * S128 + 8 * cc) = PFS.u[k]; } \
            _Pragma("unroll") for (int k = 0; k < 2; ++k) { const int it = tid + 512 * k, dk = it >> 3, c8 = it & 7; \
                st_perm8(KDT + dk * S64, dir ? 56 - 8 * c8 : 8 * c8, dir ? rev8(PFS.k[k]) : PFS.k[k]); } \
            if constexpr (FULL) { const int pr = tid >> 3, c8 = tid & 7; st_perm8(AT + pr * S64, 8 * c8, PFS.a); } \
        } else { \
            gcl = 64.f * lg; \
            if (tid < 64) { EGS[tid] = __expf((float)(tid + 1) * lg); DKS[tid] = __expf((float)(63 - tid) * lg); } \
            { const int pr = tid >> 3, cc = tid & 7; \
                if constexpr (FULL) st_perm8(QD + pr * S64, 8 * cc, PFS.q[0]); \
                const u32x4 kd = scale8(PFS.k[0], 0.125f); \
                if constexpr (FULL) st_perm8(KNAT + pr * S64, 8 * cc, kd); \
                const unsigned w_[4] = {kd.x, kd.y, kd.z, kd.w}; \
                _Pragma("unroll") for (int e = 0; e < 4; ++e) { KDT[(8 * cc + 2 * e) * S64 + kperm(pr)] = (bf16_t)(w_[e] & 0xffffu); KDT[(8 * cc + 2 * e + 1) * S64 + kperm(pr)] = (bf16_t)(w_[e] >> 16); } } \
            _Pragma("unroll") for (int k = 0; k < 2; ++k) { const int it = tid + 512 * k, pr = it >> 4, cc = it & 15; *(LAS u32x4*)(UU + pr * S128 + 8 * cc) = PFS.u[k]; } \
        } \
        if constexpr (FULL) { if (n > 0) SCAN_STORE_O(CHUNK_OF(n - 1)); } \
        SCAN_BAR(); \
        scan_load<GDN, FULL>(PFS, ws, E, SO, dir, h, CHUNK_OF(n + 2 < ns ? n + 2 : ns - 1), gcbase + (SET) * 256); \
        if constexpr (!GDN && FULL) { \
            _Pragma("unroll") for (int e = 0; e < 2; ++e) { const int tt = 2 * wave + e, mt = tt >> 2, nt = tt & 3; \
                f32x4 acc = {0.f, 0.f, 0.f, 0.f}; \
                if (nt <= mt) { \
                    _Pragma("unroll") for (int s = 0; s < 2; ++s) acc = mfma16(*(const LAS bf16x8*)(QD + (16 * mt + fr) * S64 + 32 * s + 8 * g), *(const LAS bf16x8*)(KNAT + (16 * nt + fr) * S64 + 32 * s + 8 * g), acc); \
                } \
                _Pragma("unroll") for (int r = 0; r < 4; ++r) { const int i = 16 * mt + 4 * g + r, j = 16 * nt + fr; \
                    AT[i * S64 + kperm(j)] = f2bf(j <= i ? acc[r] * __expf((float)(i - j) * lg) : 0.f); } } \
            SCAN_BAR(); \
        } \
        { \
        const float cd = __expf(gcl); \
        bf16x8 Sb[NKS], Db[TRK ? NKS : 1]; \
        _Pragma("unroll") for (int s = 0; s < NKS; ++s) Sb[s] = pack8(S[2 * s], S[2 * s + 1]); \
        if constexpr (TRK) { _Pragma("unroll") for (int s = 0; s < NKS; ++s) Db[s] = pack8(D[2 * s], D[2 * s + 1]); } \
        f32x4 vn[4], oi[FULL ? 4 : 1], vd[TRK ? 4 : 1]; \
          \
        constexpr bool PFQ = FULL && !GDN;              \
        bf16x8 fq[PFQ ? NKS : 1], fw[GDN ? NKS : 1]; \
        if constexpr (PFQ) { _Pragma("unroll") for (int s = 0; s < NKS; ++s) fq[s] = afrag(QD, SQ, 0, s, fr, g); } \
        if constexpr (GDN) { _Pragma("unroll") for (int s = 0; s < NKS; ++s) fw[s] = afrag(WW, S128, 0, s, fr, g); } \
        _Pragma("unroll") for (int mt = 0; mt < 4; ++mt) { \
            bf16x8 nq[PFQ ? NKS : 1], nw[GDN ? NKS : 1]; \
            if (mt < 3) { if constexpr (PFQ) { _Pragma("unroll") for (int s = 0; s < NKS; ++s) nq[s] = afrag(QD, SQ, 16 * (mt + 1), s, fr, g); } \
                          if constexpr (GDN) { _Pragma("unroll") for (int s = 0; s < NKS; ++s) nw[s] = afrag(WW, S128, 16 * (mt + 1), s, fr, g); } } \
            f32x4 uu; \
            _Pragma("unroll") for (int r = 0; r < 4; ++r) uu[r] = bf2f(UU[(16 * mt + 4 * g + r) * S128 + col]); \
            asm volatile("" ::: "memory"); \
            if constexpr (FULL) { f32x4 o = {0.f, 0.f, 0.f, 0.f}; \
                _Pragma("unroll") for (int s = 0; s < NKS; ++s) o = mfma16(PFQ ? fq[s] : afrag(QD, SQ, 16 * mt, s, fr, g), Sb[s], o); \
                oi[mt] = o * *(const LAS f32x4*)(EGS + 16 * mt + 4 * g); } \
            if constexpr (GDN) { f32x4 t = {0.f, 0.f, 0.f, 0.f}, td = {0.f, 0.f, 0.f, 0.f}; \
                _Pragma("unroll") for (int s = 0; s < NKS; ++s) { t = mfma16(fw[s], Sb[s], t); if constexpr (TRK) td = mfma16(fw[s], Db[s], td); } \
                vn[mt] = uu - t; \
                if constexpr (TRK) { f32x4 wc_; _Pragma("unroll") for (int r = 0; r < 4; ++r) wc_[r] = bf2f(WW[(16 * mt + 4 * g + r) * S128 + kperm(col)]); vd[mt] = wc_ * (-crun) - td; } \
            } else vn[mt] = uu; \
            if (mt < 3) { if constexpr (PFQ) { _Pragma("unroll") for (int s = 0; s < NKS; ++s) fq[s] = nq[s]; } \
                          if constexpr (GDN) { _Pragma("unroll") for (int s = 0; s < NKS; ++s) fw[s] = nw[s]; } } \
        } \
        bf16x8 vb[FULL ? 2 : 1], vk[2], vkd[TRK ? 2 : 1]; \
        if constexpr (FULL) { vb[0] = pack8(vn[0], vn[1]); vb[1] = pack8(vn[2], vn[3]); } \
        _Pragma("unroll") for (int s = 0; s < 2; ++s) { const f32x4 d0 = *(const LAS f32x4*)(DKS + 32 * s + 4 * g), d1 = *(const LAS f32x4*)(DKS + 32 * s + 16 + 4 * g); \
            vk[s] = pack8(vn[2 * s] * d0, vn[2 * s + 1] * d1); if constexpr (TRK) vkd[s] = pack8(vd[2 * s] * d0, vd[2 * s + 1] * d1); } \
        if constexpr (FULL) { \
        _Pragma("unroll") for (int mt = 0; mt < 4; ++mt) { \
            f32x4 o = oi[mt]; \
            _Pragma("unroll") for (int s = 0; s < 2; ++s) o = mfma16(afrag(AT, S64, 16 * mt, s, fr, g), vb[s], o); \
            _Pragma("unroll") for (int r = 0; r < 4; ++r) OO[(16 * mt + 4 * g + r) * S128 + col] = f2bf(o[r]); \
        } } \
        _Pragma("unroll") for (int dt = 0; dt < NDT; ++dt) { f32x4 t = S[dt] * cd; f32x4 td; if constexpr (TRK) td = D[dt] * cd; \
            _Pragma("unroll") for (int s = 0; s < 2; ++s) { const bf16x8 kf = afrag(KDT, S64, 16 * dt, s, fr, g); t = mfma16(kf, vk[s], t); if constexpr (TRK) td = mfma16(kf, vkd[s], td); } \
            S[dt] = t; if constexpr (TRK) D[dt] = td; if ((dt & 3) == 3) asm volatile("" ::: "memory"); } \
        crun *= cd; \
        } } while (0)
    ScanPF PA, PB;
    const unsigned gcbase = (unsigned)(uintptr_t)(L + SL_GCP);
    ScanOff SO; scan_offsets<GDN>(SO, tid, dir, h);
    scan_load<GDN, FULL>(PA, ws, E, SO, dir, h, CHUNK_OF(0), gcbase);
    scan_load<GDN, FULL>(PB, ws, E, SO, dir, h, CHUNK_OF(1), gcbase + 256);
    constexpr int NL = GDN ? (FULL ? 10 : 7) : (FULL ? 4 : 3), NS = FULL ? 2 : 0;
    SCAN_STEP(PA, 0, 0, NL); SCAN_STEP(PB, 1, 1, NL);
#pragma unroll 1
    for (int nn = 2; nn < ns; nn += 2) { SCAN_STEP(PA, 0, nn, NL + NS); SCAN_STEP(PB, 1, nn + 1, NL + NS); }
    scan_wait<GDN, FULL, 0>(PA); scan_wait<GDN, FULL, 0>(PB);
    __syncthreads();
    lane = fresh_lane(); tid = wave * 64 + lane; g = lane >> 4; fr = lane & 15; col = 16 * wave + fr;
    if constexpr (FULL) SCAN_STORE_O(CHUNK_OF(ns - 1));
    if constexpr (MODE == 0) { float* so = as_global(P.out) + (GDN ? OUT_SGDN : OUT_SRET) + (size_t)((seq * 2 + dir) * 4 + h) * DK * 128;
#pragma unroll
        for (int dt = 0; dt < NDT; ++dt)
#pragma unroll
            for (int r = 0; r < 4; ++r) so[(16 * dt + 4 * g + r) * 128 + col] = S[dt][r]; }
    if constexpr (MODE == 1) {
#pragma unroll
        for (int dt = 0; dt < NDT; ++dt)
#pragma unroll
            for (int r = 0; r < 4; ++r) sgb[(16 * dt + 4 * g + r) * 128 + col] = S[dt][r];
        if constexpr (TRK) { bf16_t* dl = (bf16_t*)(ws + WS_DLT) + ((size_t)ci * SNG + gi) * 16384;
#pragma unroll
            for (int dt = 0; dt < NDT; ++dt)
#pragma unroll
                for (int r = 0; r < 4; ++r) dl[(16 * dt + 4 * g + r) * 128 + kperm(col)] = f2bf(D[dt][r]);
            if (tid == 0) ((float*)(ws + WS_CG))[ci * SNG + gi] = crun; }
    }
#undef SCAN_STEP
#undef SCAN_STORE_O
#undef CHUNK_OF
}
__device__ __forceinline__ void run_ctx_chain(const Frame& F, const Params& P, unsigned char* ws, int c, bool dummy) {
    const bool gdn = c < 128; const int idx = gdn ? c : c - 128;
    if (gdn) scan_unit<true, 0>(F, P, ws, idx >> 3, (idx >> 1) & 3, idx & 1, 0, dummy);
    else scan_unit<false, 0>(F, P, ws, idx >> 3, (idx >> 1) & 3, idx & 1, 0, dummy);
}
__device__ __forceinline__ void phase_scan1(const Frame& F, const Params& P, unsigned char* ws) {
#pragma unroll 1
    for (int u = F.bid; u < 64 * SNG; u += F.nb) { const int ci = (u / SNG) & 31, gi = u % SNG;
        if (gi == SNG - 1) continue;
        if (u < 32 * SNG) scan_unit<true, 1>(F, P, ws, ci >> 3, (ci >> 1) & 3, ci & 1, gi, false);
        else scan_unit<false, 1>(F, P, ws, ci >> 3, (ci >> 1) & 3, ci & 1, gi, false); }
    if (F.nb == 64 * SNG && SNG == 4) {
        const int u = F.bid, gi = u & 3;
        int c0 = 0, nc = 0;
        if (gi == 3) { c0 = 2 * (u >> 2); nc = 2; }
        else if (u >= 128) { c0 = 128 + 3 * ((u - 128) >> 2) + gi; nc = 1; }
#pragma unroll 1
        for (int t = 0; t < nc; ++t) run_ctx_chain(F, P, ws, c0 + t, false);
    }
}
__device__ __forceinline__ void phase_scan(const Frame& F, const Params& P, unsigned char* ws, bool dummy) {
#pragma unroll 1
    for (int u = F.bid; u < 64 * SNG; u += F.nb) { const int ci = (u / SNG) & 31, gi = u % SNG;
        if (u < 32 * SNG) scan_unit<true, 3>(F, P, ws, ci >> 3, (ci >> 1) & 3, ci & 1, gi, dummy);
        else scan_unit<false, 3>(F, P, ws, ci >> 3, (ci >> 1) & 3, ci & 1, gi, dummy); }
    int c0 = F.bid, c1 = 256, cs = F.nb;
    if (F.nb == 64 * SNG && SNG == 4) {
        const int u = F.bid;
        if (u >= 128 && (u & 3) == 0) { c0 = 224 + ((u - 128) >> 2); c1 = c0 + 1; } else { c0 = 256; }
    }
#pragma unroll 1
    for (int c = c0; c < c1; c += cs) run_ctx_chain(F, P, ws, c, dummy);
    if (F.nb == 64 * SNG && SNG == 4 && !dummy) {
        const int u = F.bid;
        if (u >= 128 && (u & 3) != 0) { __syncthreads(); Frame G = F; G.gw = (3 * ((u - 128) >> 2) + (u & 3) - 1) * 8 + F.wave; G.ngw = 96 * 8; conv_l0_half(G, P, 1, ws); conv_l1_a2(G, P, ws); }
    }
}

__device__ __forceinline__ void combine_half(u32x4 of, u32x4 ob, u32x4 gt, const f32x4 w0, const f32x4 w1, bf16_t* dst) {
    float o[8] = {bflo(of.x) + bflo(ob.x), bfhi(of.x) + bfhi(ob.x), bflo(of.y) + bflo(ob.y), bfhi(of.y) + bfhi(ob.y), bflo(of.z) + bflo(ob.z), bfhi(of.z) + bfhi(ob.z), bflo(of.w) + bflo(ob.w), bfhi(of.w) + bfhi(ob.w)};
    const float gv[8] = {bflo(gt.x), bfhi(gt.x), bflo(gt.y), bfhi(gt.y), bflo(gt.z), bfhi(gt.z), bflo(gt.w), bfhi(gt.w)};
    float ss = 0.f;
#pragma unroll
    for (int e = 0; e < 8; ++e) ss += o[e] * o[e];
    ss = row16_sum(ss);
    const float rs = 1.0f / sqrtf(ss * (1.f / 128.f) + EPS);
    const float wv[8] = {w0.x, w0.y, w0.z, w0.w, w1.x, w1.y, w1.z, w1.w};
    float y[8];
#pragma unroll
    for (int e = 0; e < 8; ++e) y[e] = o[e] * rs * wv[e] * silu_f(gv[e]);
    *(u32x4*)dst = (u32x4){pk2(y[0], y[1]), pk2(y[2], y[3]), pk2(y[4], y[5]), pk2(y[6], y[7])};
}
__device__ __forceinline__ void phase_combine(const Frame& F, const Params& P, unsigned char* ws) {
    const bf16_t* E = (const bf16_t*)(ws + WS_BIG); const bf16_t* U = (const bf16_t*)(ws + WS_U); bf16_t* MIX = (bf16_t*)(ws + WS_XN);
    const int hh = F.lane >> 4, c0 = 8 * (F.lane & 15);
    const f32x4 rw0 = *(const f32x4*)(as_global(P.ret_norm_w) + c0), rw1 = *(const f32x4*)(as_global(P.ret_norm_w) + c0 + 4);
    const f32x4 gw0 = *(const f32x4*)(as_global(P.gdn_norm_w) + c0), gw1 = *(const f32x4*)(as_global(P.gdn_norm_w) + c0 + 4);
    for (int m0 = F.gw; m0 < MROWS; m0 += 4 * F.ngw) {
        u32x4 v[4][6]; int mr[4];
#pragma unroll
        for (int r = 0; r < 4; ++r) { const int mm = m0 + r * F.ngw; const int m = mm < MROWS ? mm : m0; mr[r] = mm < MROWS ? mm : -1; const int chunk = m >> 6, p = m & 63;
            const bf16_t* er = E + (size_t)m * EVN + hh * 128 + c0;
            v[r][0] = *(const u32x4*)(er + EC_GQ); v[r][1] = *(const u32x4*)(er + EC_GK); v[r][2] = *(const u32x4*)(er + EC_RG);
            v[r][3] = *(const u32x4*)(U + ((size_t)(0 * NCHUNK + chunk) * 4 + hh) * 8192 + p * 128 + c0); v[r][4] = *(const u32x4*)(U + ((size_t)(1 * NCHUNK + chunk) * 4 + hh) * 8192 + (63 - p) * 128 + c0);
            v[r][5] = *(const u32x4*)(er + EC_GG); }
        asm volatile("" :: "v"(v[0][0]), "v"(v[0][1]), "v"(v[0][2]), "v"(v[0][3]), "v"(v[0][4]), "v"(v[0][5]), "v"(v[1][0]), "v"(v[1][1]), "v"(v[1][2]), "v"(v[1][3]), "v"(v[1][4]), "v"(v[1][5]),
                     "v"(v[2][0]), "v"(v[2][1]), "v"(v[2][2]), "v"(v[2][3]), "v"(v[2][4]), "v"(v[2][5]), "v"(v[3][0]), "v"(v[3][1]), "v"(v[3][2]), "v"(v[3][3]), "v"(v[3][4]), "v"(v[3][5]) : "memory");
#pragma unroll
        for (int r = 0; r < 4; ++r) { const int m = mr[r]; if (m < 0) continue;
            combine_half(v[r][0], v[r][1], v[r][2], rw0, rw1, MIX + (size_t)m * 1024 + hh * 128 + c0);
            combine_half(v[r][3], v[r][4], v[r][5], gw0, gw1, MIX + (size_t)m * 1024 + 512 + hh * 128 + c0); }
    }
}
__device__ __forceinline__ void conv_l1_a1(const Frame& F, const Params& P, unsigned char* ws) {
    LAS float* scr = (LAS float*)(F.lds + F.wave * 16384);
    conv_swiglu(F, as_global(P.ffn_w_in) + (size_t)(1 * 2 + 0) * DM * FF2, (bf16_t*)(ws + WS_WFIN0), scr);
    conv_plain(F, as_global(P.ffn_w_out) + (size_t)(1 * 2 + 0) * FFH * DM, FFH, DM, DM, (bf16_t*)(ws + WS_WFOUT0), scr, true);
}
__device__ __forceinline__ void conv_l1_b1(const Frame& F, const Params& P, unsigned char* ws) {
    LAS float* scr = (LAS float*)(F.lds + F.wave * 16384);
    conv_swiglu(F, as_global(P.ffn_w_in) + (size_t)(1 * 2 + 1) * DM * FF2, (bf16_t*)(ws + WS_WFIN1), scr);
}
__device__ __forceinline__ void conv_l1_b2(const Frame& F, const Params& P, unsigned char* ws) {
    LAS float* scr = (LAS float*)(F.lds + F.wave * 16384);
    conv_plain(F, as_global(P.ffn_w_out) + (size_t)(1 * 2 + 1) * FFH * DM, FFH, DM, DM, (bf16_t*)(ws + WS_WFOUT1), scr, true);
}
__device__ __forceinline__ void conv_odd_out(const Frame& F, const Params& P, unsigned char* ws) {
    LAS float* scr = (LAS float*)(F.lds + F.wave * 16384);
    conv_plain(F, as_global(P.odd_w_out), DM, DM, DM, (bf16_t*)(ws + WS_WMOUT), scr);
}
__device__ __forceinline__ void phase_conv_l1(const Frame& F, const Params& P, unsigned char* ws) {
    if (F.nb != 256) { conv_l1_a1(F, P, ws); conv_l1_a2(F, P, ws); conv_l1_b1(F, P, ws); conv_l1_b2(F, P, ws); }
    if (F.nb != 256) conv_odd_out(F, P, ws);
}
__device__ __forceinline__ void conv_cache_kv(const Params& P, unsigned char* ws, int gt, int ngt) {
    bf16_t* KL = (bf16_t*)(ws + WS_KL); bf16_t* VL = (bf16_t*)(ws + WS_VL);
    const float* ck = as_global(P.cache_k); const float* cv = as_global(P.cache_v);
    for (int i = gt; i < 4 * 512 * 256 / 8; i += ngt) {
        const int b = i >> 14, rem = i & 16383;
        const f32x4 k0 = *(const f32x4*)(ck + (size_t)i * 8), k1 = *(const f32x4*)(ck + (size_t)i * 8 + 4);
        const f32x4 v0 = *(const f32x4*)(cv + (size_t)i * 8), v1 = *(const f32x4*)(cv + (size_t)i * 8 + 4);
        *(u32x4*)(KL + (size_t)b * 4608 * 256 + (size_t)rem * 8) = (u32x4){pk2(k0.x, k0.y), pk2(k0.z, k0.w), pk2(k1.x, k1.y), pk2(k1.z, k1.w)};
        *(u32x4*)(VL + (size_t)b * 4608 * 256 + (size_t)rem * 8) = (u32x4){pk2(v0.x, v0.y), pk2(v0.z, v0.w), pk2(v1.x, v1.y), pk2(v1.z, v1.w)};
    }
}
constexpr int NTHREADS = 512, LDS_BYTES = 163840;
#ifndef PROBE
#define PROBE 0
#endif
#ifndef PREP_SKIP
#define PREP_SKIP 13
#endif
#ifndef DBG_STOP
#define DBG_STOP 99
#endif

__device__ __forceinline__ void attention_phase(const Frame& F, const Params& P, unsigned char* ws, char* lds, size_t o_off) {
    using abf = attn_body::bf16;
    const abf* QS = (const abf*)(ws + WS_BIG); abf* O = (abf*)(ws + o_off);
    const float* qnw = as_global(P.q_norm_w); const float* rope = (const float*)(ws + WS_ROPE);
    for (int k = 0; k < 4; ++k) {
        const int u = F.bid + F.nb * k; if (u >= 1024) break;
        const int b = u >> 8, h = (u >> 4) & 15, qb = u & 15;
        const size_t r0 = (size_t)NPR + (size_t)b * 4096 + 256 * qb;
        const abf* kh = (const abf*)(ws + WS_KL) + (size_t)b * 4608 * 256 + (h >> 2) * 64; const abf* vh = (const abf*)(ws + WS_VL) + (size_t)b * 4608 * 256 + (h >> 2) * 64;
        attn_body::attn_unit<8>(QS + r0 * 1536 + h * 64, kh, vh, O + r0 * 1024 + h * 64, 72, lds, F.wave, qnw, rope, 256 * qb);
    }
    for (int u = F.bid; u < 256; u += F.nb) {
        const int b = u >> 4, h = u & 15;
        const size_t r0 = (size_t)b * 256;
        const abf* kh = (const abf*)(ws + WS_KP) + (size_t)b * 256 * 256 + (h >> 2) * 64; const abf* vh = (const abf*)(ws + WS_VP) + (size_t)b * 256 * 256 + (h >> 2) * 64;
        attn_body::attn_unit<8>(QS + r0 * 1536 + h * 64, kh, vh, O + r0 * 1024 + h * 64, 4, lds, F.wave, qnw, rope, -1);
    }
}

__device__ __forceinline__ int opaque_u(int v) { v = __builtin_amdgcn_readfirstlane(v); asm volatile("" : "+s"(v)); return v; }
__device__ __forceinline__ unsigned char* opaque_ptr(unsigned char* p) {
    unsigned lo = __builtin_amdgcn_readfirstlane((unsigned)(uintptr_t)p), hi = __builtin_amdgcn_readfirstlane((unsigned)((uintptr_t)p >> 32));
    asm volatile("" : "+s"(lo), "+s"(hi));
    return as_global((unsigned char*)(((uintptr_t)hi << 32) | (uintptr_t)lo));
}
template <class Epi>
__device__ __forceinline__ void run_gemm(const Frame& F, const bf16_t* A, const bf16_t* Bt, int N, int K, const Epi& E) {
    pg8::Gemm g{A, Bt, MROWS, N, K, false}; pg8::StaticOrder S; S.init(MROWS, N, K, F.nb, F.bid);
    pg8::gemm_phase<Epi, pg8::StaticOrder, true, true>(F.lds, g, S, E, F.wave);
}
__device__ __forceinline__ void run_gemm_ts(const Frame& F, const bf16_t* A, const bf16_t* Bt, int K, const pg8::EpiResid E, const bool tiled = false) {
    pg8::Gemm g{A, Bt, MROWS, DM, K, tiled}; pg8::TailSplit S; S.init(MROWS, DM, K, F.nb, F.bid);
    pg8::gemm_phase<pg8::EpiResid, pg8::TailSplit, true, true>(F.lds, g, S, E, F.wave);
}

__global__ void __launch_bounds__(NTHREADS, 2) mega_fwd(Params PA) {
    extern __shared__ __attribute__((aligned(16))) unsigned char lds[];
    Frame F; F.lds = (LAS unsigned char*)lds; F.wave = __builtin_amdgcn_readfirstlane((int)threadIdx.x >> 6); F.lane = fresh_lane(); F.tid = F.wave * 64 + F.lane;
    F.bid = blockIdx.x; F.nb = gridDim.x; F.gw = F.bid * 8 + F.wave; F.ngw = F.nb * 8;
    unsigned char* ws = PA.ws;
    float* X = PA.out;
    if (F.tid == 0) *(Params*)(ws + WS_PTAB) = PA;
    const Params* pt = (const Params*)opaque_ptr(ws + WS_PTAB);
    const Params& P = *pt;
    const float* MOD = (const float*)(ws + WS_MOD);
    bf16_t* XN = (bf16_t*)(ws + WS_XN); bf16_t* BIG = (bf16_t*)(ws + WS_BIG);
    volatile LAS unsigned* bst = (volatile LAS unsigned*)(F.lds + LDS_BYTES - 64);
    if (F.tid < 2) bst[F.tid] = 0u;
    __syncthreads();
    const unsigned bar_x = xcd_barrier_post((unsigned*)(ws + WS_CTL), bst, F.tid == 0).x;
#define SYNC() do { { XcdBarrier b_; b_.bar = (unsigned*)(ws + WS_CTL); b_.x = (unsigned)opaque_u((int)bar_x); b_.st = bst; xcd_barrier(b_, F.tid == 0); } F.bid = opaque_u(F.bid); F.wave = opaque_u(F.wave); ws = opaque_ptr(ws); X = (float*)opaque_ptr((unsigned char*)X); F.lane = fresh_lane(); F.tid = F.wave * 64 + F.lane; F.gw = F.bid * 8 + F.wave; } while (0)
#define STOP(k) do { if (DBG_STOP == (k)) return; } while (0)

_Pragma("unroll 1") for (int rep = 0; rep < (PROBE == 15 ? 2 : 1); ++rep) {
    phase_p0(F, PA, ws); SYNC(); STOP(0);
    }
    bf16_t* SLAB = (bf16_t*)(ws + WS_SLAB); const bf16_t* fslab = (F.nb == 256) ? SLAB : nullptr;
#pragma unroll 1
    for (int l = 0; l < 2; ++l) {
        const float* modl = MOD + (size_t)l * 5 * 9216;
#pragma unroll 1
        for (int half = 0; half < 2; ++half) {
            const bool first = (l == 0 && half == 0);
            const float* xp = first ? as_global(P.x_prompt) : X; const float* xs = first ? as_global(P.x_sample) : X + (size_t)NPR * 1024;
            phase_norm(F, P, ws, xp, xs, xs, l, 2 * half, first ? (const bf16_t*)nullptr : fslab, half == 0 ? MOD : modl, 8 - 3 * half, half == 0 ? 0.5f : 1.0f);
            if (l == 1 && half == 0 && F.nb != 256) { __syncthreads(); phase_conv_l1(F, P, ws); }
            SYNC();
_Pragma("unroll 1") for (int rep = 0; rep < (PROBE == 1 ? 2 : 1); ++rep) {
            run_gemm(F, XN, (const bf16_t*)(ws + (half ? WS_WFIN1 : WS_WFIN0)), FF2, DM, pg8::EpiSwiGLU{BIG, FFH});
            if ((half == 0 || l == 0) && F.nb == 256 && F.bid >= 224) { __syncthreads(); Frame G = F; G.gw = (F.bid - 224) * 8 + F.wave; G.ngw = 32 * 8;
                if (half == 1) conv_odd_out(G, P, ws); else if (l == 1) conv_l1_b1(G, P, ws); else { conv_l0_out(G, P, 0, ws); conv_even_in(G, P, ws); } }
            SYNC();
            }
_Pragma("unroll 1") for (int rep = 0; rep < (PROBE == 2 ? 2 : 1); ++rep) {
            run_gemm_ts(F, BIG, (const bf16_t*)(ws + (half ? WS_WFOUT1 : WS_WFOUT0)), FFH, pg8::EpiResid{xp, xs, X, modl, SLAB, 2 + 6 * half, 0.5f}, true);
            SYNC();
            }
            if (first) STOP(1);
            if (half == 1) break;
_Pragma("unroll 1") for (int rep = 0; rep < ((PROBE == 12 && l == 0) ? 2 : 1); ++rep) {
            if (l == 0) phase_norm_gates(F, P, ws, X, X + (size_t)NPR * 1024, fslab ? xs : X + (size_t)NPR * 1024, fslab, modl, 2, 0.5f);
            else phase_norm(F, P, ws, X, X + (size_t)NPR * 1024, fslab ? xs : X + (size_t)NPR * 1024, l, 1, fslab, modl, 2, 0.5f);
            SYNC();
            }
            if (l == 0) {
                run_gemm(F, XN, (const bf16_t*)(ws + WS_WMIN), EVN, DM, pg8::EpiBf16{BIG, EVN});
                if (F.nb == 256 && F.bid >= 96) { __syncthreads(); Frame G = F; G.gw = (F.bid - 96) * 8 + F.wave; G.ngw = 160 * 8; conv_l1_a1(G, P, ws); conv_even_out(G, P, ws); __syncthreads(); phase_mod<false>(F, P, ws, 72, 144, F.bid - 96, 160); }
            } else {
                LAS float* rtl = (LAS float*)(F.lds + 131072);
                { const float* RT = (const float*)(ws + WS_ROPE); for (int i = F.tid; i < 2048; i += 512) rtl[i] = RT[i]; if (F.tid < 64) rtl[2048 + F.tid] = as_global(P.k_norm_w)[F.tid]; }
                __syncthreads();
                run_gemm(F, XN, (const bf16_t*)(ws + WS_WMIN), ODN, DM, pg8::EpiOddIn{BIG, ws, X, rtl});
                if (F.nb == 256 && F.bid >= 224) { __syncthreads(); Frame G = F; G.gw = (F.bid - 224) * 8 + F.wave; G.ngw = 32 * 8; conv_l1_b2(G, P, ws); conv_cache_kv(P, ws, G.gw * 64 + F.lane, G.ngw * 64); }
                else if (F.nb != 256) conv_cache_kv(P, ws, F.gw * 64 + F.lane, F.ngw * 64);
            }
            SYNC();
            if (l == 0) {
_Pragma("unroll 1") for (int rep = 0; rep < (PROBE == 4 ? 2 : 1); ++rep) {
_Pragma("unroll 1") for (int rep2 = 0; rep2 < (PROBE == 3 ? 2 : 1); ++rep2) {
                phase_gdn_prep(F, P, ws, (PROBE == 3 && rep2 == 0) ? PREP_SKIP : 0); SYNC();
                }
                phase_scan1(F, P, ws); SYNC();
_Pragma("unroll 1") for (int rep3 = (PROBE == 8 ? 0 : 1); rep3 < 2; ++rep3) {
                phase_scan(F, P, ws, rep3 == 0); SYNC(); STOP(2);
                }
                }
_Pragma("unroll 1") for (int rep = 0; rep < (PROBE == 13 ? 2 : 1); ++rep) {
                phase_combine(F, P, ws); SYNC();
                }
            } else {
_Pragma("unroll 1") for (int rep = (PROBE == 6 ? 0 : 1); rep < 2; ++rep) {
                attention_phase(F, P, ws, (char*)lds, WS_Q); SYNC();
                }
            }
            run_gemm_ts(F, l == 0 ? XN : (const bf16_t*)(ws + WS_Q), (const bf16_t*)(ws + WS_WMOUT), DM, pg8::EpiResid{X, X + (size_t)NPR * 1024, X, modl, SLAB, 5, 1.0f}); SYNC();
        }
    }
    phase_final(F, P, fslab, MOD + (size_t)1 * 5 * 9216, 8, 0.5f);
}

extern "C" void kernel_launch(void* const* d_in, const int* in_sizes, int n_in, void* d_out, int out_size, void* d_ws, size_t ws_size, hipStream_t stream) {
    static int grid = 0;
    if (grid == 0) {
        if (n_in != 26 || (size_t)out_size != OUT_END || ws_size < WS_END) { fprintf(stderr, "kernel_launch: unexpected problem (n_in %d, out %d, ws %zu)\n", n_in, out_size, ws_size); grid = -1; return; }
        int dev = 0, cus = 0, per_cu = 0;
        hipGetDevice(&dev); hipDeviceGetAttribute(&cus, hipDeviceAttributeMultiprocessorCount, dev);
        if (hipFuncSetAttribute((const void*)mega_fwd, hipFuncAttributeMaxDynamicSharedMemorySize, LDS_BYTES) != hipSuccess) { fprintf(stderr, "kernel_launch: hipFuncSetAttribute failed\n"); grid = -1; return; }
        if (hipOccupancyMaxActiveBlocksPerMultiprocessor(&per_cu, (const void*)mega_fwd, NTHREADS, LDS_BYTES) != hipSuccess || per_cu < 1) { fprintf(stderr, "kernel_launch: occupancy query says %d\n", per_cu); per_cu = 1; }
        (void)hipGetLastError();
        grid = cus;
        fprintf(stderr, "kernel_launch: grid %d (occupancy query %d per CU), ws %zu\n", grid, per_cu, ws_size);
    }
    if (grid < 0) return;
    if (hipMemsetAsync((char*)d_ws + WS_CTL, 0, 65536, stream) != hipSuccess) { fprintf(stderr, "kernel_launch: memset failed\n"); return; }
    Params p{};
    const float** pp = (const float**)&p;
    for (int i = 0; i < 26; ++i) pp[i] = (const float*)d_in[i];
    p.out = (float*)d_out; p.ws = (unsigned char*)d_ws;
    void* args[] = {&p};
    hipError_t e = hipLaunchCooperativeKernel((const void*)mega_fwd, dim3(grid), dim3(NTHREADS), args, LDS_BYTES, stream);
    if (e != hipSuccess) fprintf(stderr, "cooperative launch failed: %s (grid %d)\n", hipGetErrorString(e), grid);
}
```
